# Optimizing an MI355X kernel written in HIP

```python
import math
import jax
import jax.numpy as jnp
from jax import lax
import numpy as np

D_MODEL = 1024
BATCH = 8
SEQ = 2048
DEPTH = 4

CTX_LEN = 256
GRID_W = 64
HEAD_DIM = 64
MIX_W = D_MODEL
A_HEADS = D_MODEL // (4 * HEAD_DIM)
A_DK = HEAD_DIM // 2
A_DV = HEAD_DIM
A_W = A_HEADS * HEAD_DIM
B_HEADS = 3 * D_MODEL // (8 * HEAD_DIM)
B_KV_HEADS = 2
B_W = B_HEADS * HEAD_DIM
B_KV_W = B_KV_HEADS * HEAD_DIM
C_HEADS = 3 * D_MODEL // (8 * HEAD_DIM)
C_W = C_HEADS * HEAD_DIM
WIN_H = 8
WIN_W = 16
Q_BLOCK = 128
ROPE_THETA = 10000.0
EPS = 1e-6
SPLIT_SIZES = (A_W, A_W, A_W, A_W, B_W, B_KV_W, B_KV_W, B_W, C_W, C_W, C_W, C_W)
IN_W = sum(SPLIT_SIZES)

kernel_name = 'hybrid_diff_gqa_natten_prefix_dit'


def rms_norm(x, g):
    xf = x.astype(jnp.float32)
    y = xf * lax.rsqrt(jnp.mean(xf * xf, axis=-1, keepdims=True) + EPS)
    return (y * g.astype(jnp.float32)).astype(x.dtype)


def axial_rope(x, row, col):
    d = x.shape[-1]
    nf = d // 4
    inv = ROPE_THETA ** (-jnp.arange(nf, dtype=jnp.float32) / nf)
    ang = jnp.concatenate([row[:, None] * inv, col[:, None] * inv], axis=-1)
    shape = (1, x.shape[1]) + (1,) * (x.ndim - 3) + (d // 2,)
    cos = jnp.cos(ang).reshape(shape)
    sin = jnp.sin(ang).reshape(shape)
    xf = x.astype(jnp.float32)
    x1, x2 = xf[..., : d // 2], xf[..., d // 2:]
    return jnp.concatenate([x1 * cos - x2 * sin, x2 * cos + x1 * sin], axis=-1).astype(x.dtype)


def map_query_blocks(fn, q):
    b, s = q.shape[:2]
    nb = s // Q_BLOCK
    qb = jnp.moveaxis(q.reshape((b, nb, Q_BLOCK) + q.shape[2:]), 1, 0)
    out = lax.map(fn, qb)
    return jnp.moveaxis(out, 0, 1).reshape((b, s) + out.shape[3:])


def diff_attend(q, k, v, lam):
    s = jnp.einsum('bqhmd,bkhmd->bhmqk', q, k).astype(jnp.float32) * (q.shape[-1] ** -0.5)
    p = jax.nn.softmax(s, axis=-1)
    a = (p[:, :, 0] - lam * p[:, :, 1]).astype(v.dtype)
    return jnp.einsum('bhqk,bkhd->bqhd', a, v)


def gqa_attend(q, k, v):
    b, nq, h, d = q.shape
    kvh = k.shape[2]
    qg = q.reshape(b, nq, kvh, h // kvh, d)
    s = jnp.einsum('bqhgd,bkhd->bhgqk', qg, k).astype(jnp.float32) * (d ** -0.5)
    p = jax.nn.softmax(s, axis=-1).astype(v.dtype)
    o = jnp.einsum('bhgqk,bkhd->bqhgd', p, v)
    return o.reshape(b, nq, h * v.shape[-1])


def neighbourhood_attend(q, k, v, k_ctx, v_ctx, rpb, rows):
    b, s, h, d = q.shape
    kh = min(WIN_H, rows)
    kw = WIN_W
    scale = d ** -0.5
    qg = q.reshape(b, rows, GRID_W, h, d)
    kg = k.reshape(b, rows, GRID_W, h, d)
    vg = v.reshape(b, rows, GRID_W, h, d)
    r = jnp.arange(rows)
    cidx = jnp.arange(GRID_W)
    r0 = jnp.clip(r - kh // 2, 0, rows - kh)
    key_rows = r0[:, None] + jnp.arange(kh)
    k_blk = kg[:, key_rows]
    v_blk = vg[:, key_rows]
    c0 = jnp.clip(cidx - kw // 2, 0, GRID_W - kw)
    in_win = (cidx[None, :] >= c0[:, None]) & (cidx[None, :] < c0[:, None] + kw)
    dr = key_rows - r[:, None] + (WIN_H - 1)
    dc = jnp.clip(cidx[None, :] - cidx[:, None] + (WIN_W - 1), 0, 2 * WIN_W - 2)
    bias = rpb[:, dr[:, None, :, None], dc[None, :, None, :]]
    s_nb = jnp.einsum('brqhd,brkwhd->bhrqkw', qg, k_blk).astype(jnp.float32) * scale
    s_nb = s_nb + bias.astype(jnp.float32)[None]
    s_nb = jnp.where(in_win[:, None, :], s_nb, -jnp.inf)
    s_cx = jnp.einsum('brqhd,bchd->bhrqc', qg, k_ctx).astype(jnp.float32) * scale
    n_nb = kh * GRID_W
    sc = jnp.concatenate([s_nb.reshape(b, h, rows, GRID_W, n_nb), s_cx], axis=-1)
    p = jax.nn.softmax(sc, axis=-1).astype(v.dtype)
    p_nb = p[..., :n_nb].reshape(b, h, rows, GRID_W, kh, GRID_W)
    p_cx = p[..., n_nb:]
    o = jnp.einsum('bhrqkw,brkwhd->brqhd', p_nb, v_blk) + jnp.einsum('bhrqc,bchd->brqhd', p_cx, v_ctx)
    return o.reshape(b, s, h * d)


def split_proj(p):
    idx = np.cumsum(SPLIT_SIZES)[:-1].tolist()
    return jnp.split(p, idx, axis=-1)


def setup_inputs(seed: int = 0) -> dict:
    key = jax.random.key(seed)
    ks = jax.random.split(key, 22)
    nrm = jax.random.normal
    f32 = jnp.float32
    return {
        'x': nrm(ks[0], (BATCH, SEQ, D_MODEL), f32),
        'c': nrm(ks[1], (BATCH, D_MODEL), f32),
        'ctx': nrm(ks[2], (BATCH, CTX_LEN, D_MODEL), f32),
        'c_ctx': nrm(ks[3], (D_MODEL,), f32),
        'norm_g': 1.0 + 0.05 * nrm(ks[4], (DEPTH, D_MODEL), f32),
        'w_ada': nrm(ks[5], (DEPTH, D_MODEL, 3 * D_MODEL), f32) * (0.5 * D_MODEL ** -0.5),
        'b_ada': 0.01 * nrm(ks[6], (DEPTH, 3 * D_MODEL), f32),
        'w_in': nrm(ks[7], (DEPTH, D_MODEL, IN_W), f32) * (D_MODEL ** -0.5),
        'w_out': nrm(ks[8], (DEPTH, MIX_W, D_MODEL), f32) * (MIX_W ** -0.5),
        'diff_q_norm': 1.0 + 0.05 * nrm(ks[9], (DEPTH, A_DK), f32),
        'diff_k_norm': 1.0 + 0.05 * nrm(ks[10], (DEPTH, A_DK), f32),
        'lambda_q1': 0.1 * nrm(ks[11], (DEPTH, A_DK), f32),
        'lambda_k1': 0.1 * nrm(ks[12], (DEPTH, A_DK), f32),
        'lambda_q2': 0.1 * nrm(ks[13], (DEPTH, A_DK), f32),
        'lambda_k2': 0.1 * nrm(ks[14], (DEPTH, A_DK), f32),
        'diff_subln': 1.0 + 0.05 * nrm(ks[15], (DEPTH, A_DV), f32),
        'gqa_q_norm': 1.0 + 0.05 * nrm(ks[16], (DEPTH, HEAD_DIM), f32),
        'gqa_k_norm': 1.0 + 0.05 * nrm(ks[17], (DEPTH, HEAD_DIM), f32),
        'nat_q_norm': 1.0 + 0.05 * nrm(ks[18], (DEPTH, HEAD_DIM), f32),
        'nat_k_norm': 1.0 + 0.05 * nrm(ks[19], (DEPTH, HEAD_DIM), f32),
        'nat_rpb': 0.1 * nrm(ks[20], (DEPTH, C_HEADS, 2 * WIN_H - 1, 2 * WIN_W - 1), f32),
    }


def reference(x, c, ctx, c_ctx, norm_g, w_ada, b_ada, w_in, w_out, diff_q_norm, diff_k_norm,
              lambda_q1, lambda_k1, lambda_q2, lambda_k2, diff_subln, gqa_q_norm, gqa_k_norm,
              nat_q_norm, nat_k_norm, nat_rpb):
    b, s, _ = x.shape
    n_ctx = ctx.shape[1]
    rows = s // GRID_W
    t = jnp.arange(s)
    row = (t // GRID_W).astype(jnp.float32)
    col = (t % GRID_W).astype(jnp.float32)
    for l in range(DEPTH):
        lam_init = 0.8 - 0.6 * math.exp(-0.3 * l)
        sh, sc, gt = jnp.split(jax.nn.silu(c) @ w_ada[l] + b_ada[l], 3, axis=-1)
        sh_c, sc_c, gt_c = jnp.split(jax.nn.silu(c_ctx) @ w_ada[l] + b_ada[l], 3, axis=-1)
        h = rms_norm(x, norm_g[l]) * (1 + sc[:, None]) + sh[:, None]
        hc = rms_norm(ctx, norm_g[l]) * (1 + sc_c) + sh_c
        qa, ka, va, ga, qb, kb, vb, gb, qn, kn, vn, gn = split_proj(h @ w_in[l])
        qa_c, ka_c, va_c, ga_c, qb_c, kb_c, vb_c, gb_c, qn_c, kn_c, vn_c, gn_c = split_proj(hc @ w_in[l])

        lam = (jnp.exp(jnp.sum(lambda_q1[l] * lambda_k1[l])) - jnp.exp(jnp.sum(lambda_q2[l] * lambda_k2[l]))
               + lam_init).astype(jnp.float32)
        qa = axial_rope(rms_norm(qa.reshape(b, s, A_HEADS, 2, A_DK), diff_q_norm[l]), row, col)
        ka = axial_rope(rms_norm(ka.reshape(b, s, A_HEADS, 2, A_DK), diff_k_norm[l]), row, col)
        ka_c = rms_norm(ka_c.reshape(b, n_ctx, A_HEADS, 2, A_DK), diff_k_norm[l])
        va_c = va_c.reshape(b, n_ctx, A_HEADS, A_DV)
        ka_all = jnp.concatenate([ka, ka_c], axis=1)
        va_all = jnp.concatenate([va.reshape(b, s, A_HEADS, A_DV), va_c], axis=1)
        oa = map_query_blocks(lambda q_blk: diff_attend(q_blk, ka_all, va_all, lam), qa)
        ya = (rms_norm(oa, diff_subln[l]) * (1 - lam_init)).reshape(b, s, A_W) * jax.nn.silu(ga)

        qb = axial_rope(rms_norm(qb.reshape(b, s, B_HEADS, HEAD_DIM), gqa_q_norm[l]), row, col)
        kb = axial_rope(rms_norm(kb.reshape(b, s, B_KV_HEADS, HEAD_DIM), gqa_k_norm[l]), row, col)
        kb_c = rms_norm(kb_c.reshape(b, n_ctx, B_KV_HEADS, HEAD_DIM), gqa_k_norm[l])
        vb_c = vb_c.reshape(b, n_ctx, B_KV_HEADS, HEAD_DIM)
        kb_all = jnp.concatenate([kb, kb_c], axis=1)
        vb_all = jnp.concatenate([vb.reshape(b, s, B_KV_HEADS, HEAD_DIM), vb_c], axis=1)
        yb = map_query_blocks(lambda q_blk: gqa_attend(q_blk, kb_all, vb_all), qb) * jax.nn.silu(gb)

        qn = rms_norm(qn.reshape(b, s, C_HEADS, HEAD_DIM), nat_q_norm[l])
        kn = rms_norm(kn.reshape(b, s, C_HEADS, HEAD_DIM), nat_k_norm[l])
        kn_c = rms_norm(kn_c.reshape(b, n_ctx, C_HEADS, HEAD_DIM), nat_k_norm[l])
        vn_c = vn_c.reshape(b, n_ctx, C_HEADS, HEAD_DIM)
        yn = neighbourhood_attend(qn, kn, vn.reshape(b, s, C_HEADS, HEAD_DIM), kn_c, vn_c, nat_rpb[l], rows)
        yn = yn * jax.nn.silu(gn)

        y = jnp.concatenate([ya, yb, yn], axis=-1) @ w_out[l]

        if l < DEPTH - 1:
            qa_c = rms_norm(qa_c.reshape(b, n_ctx, A_HEADS, 2, A_DK), diff_q_norm[l])
            oa_c = diff_attend(qa_c, ka_c, va_c, lam)
            ya_c = (rms_norm(oa_c, diff_subln[l]) * (1 - lam_init)).reshape(b, n_ctx, A_W) * jax.nn.silu(ga_c)
            qb_c = rms_norm(qb_c.reshape(b, n_ctx, B_HEADS, HEAD_DIM), gqa_q_norm[l])
            yb_c = gqa_attend(qb_c, kb_c, vb_c) * jax.nn.silu(gb_c)
            qn_c = rms_norm(qn_c.reshape(b, n_ctx, C_HEADS, HEAD_DIM), nat_q_norm[l])
            yn_c = gqa_attend(qn_c, kn_c, vn_c) * jax.nn.silu(gn_c)
            ctx = ctx + gt_c * (jnp.concatenate([ya_c, yb_c, yn_c], axis=-1) @ w_out[l])

        x = x + gt[:, None] * y
    return x
```

```cpp
#include <hip/hip_runtime.h>
#include <hip/hip_cooperative_groups.h>
#include <cstdio>
#include <cstdint>
namespace cg = cooperative_groups;

#ifndef DBL
#define DBL 0
#endif
#ifndef N_LAUNCH_MODE
#define N_LAUNCH_MODE 1
#endif

#define DI __device__ __forceinline__
typedef unsigned short bf16_t;
typedef short bf16x8 __attribute__((ext_vector_type(8)));
typedef short s16x4 __attribute__((ext_vector_type(4)));
typedef float f32x16 __attribute__((ext_vector_type(16)));
typedef __bf16 bf2_t __attribute__((ext_vector_type(2)));
typedef float f2_t __attribute__((ext_vector_type(2)));
#define MFMA(a, b, c) __builtin_amdgcn_mfma_f32_32x32x16_bf16((a), (b), (c), 0, 0, 0)

constexpr int D = 1024, NB = 8, SEQ = 2048, CTXL = 256, TPB = 2304, NTOK = NB * TPB, INW = 3584, DEPTH = 4, VW = 768;
constexpr int NTHREADS = 256;
constexpr int LDS_BYTES = 73728;
constexpr int NPHASES = 1 + 4 * DEPTH;
constexpr float EPS = 1e-6f;
constexpr float LOG2E = 1.4426950408889634f;

struct Params {
    const float *x, *c, *ctx, *c_ctx, *norm_g, *w_ada, *b_ada, *w_in, *w_out;
    const float *dqn, *dkn, *lq1, *lk1, *lq2, *lk2, *subln, *gqn, *gkn, *nqn, *nkn, *rpb;
    float* out;
    float* xctx;
    bf16_t* hmix;
    bf16_t* qkv;
    bf16_t* vT;
    bf16_t* wtin;
    bf16_t* wtout;
    float* mod;
    float* rope64;
    float* rope32;
    float* lam;
    unsigned* ctr;
    unsigned* bar;
};

DI unsigned pk2(float a, float b) { f2_t v = {a, b}; bf2_t r = __builtin_convertvector(v, bf2_t); return __builtin_bit_cast(unsigned, r); }
DI float bf2f(bf16_t v) { return __uint_as_float(((unsigned)v) << 16); }
DI int otid() { int t = threadIdx.x; asm volatile("" : "+v"(t)); return t; }
typedef unsigned u32x4_t __attribute__((ext_vector_type(4)));
DI void ldg_async(u32x4_t& r, const void* p) { asm volatile("global_load_dwordx4 %0, %1, off" : "=v"(r) : "v"(p)); }
#define WAIT_LOADS8(a, b, c, d, e, f, g, h) asm volatile("s_waitcnt vmcnt(0)" : "+v"(a), "+v"(b), "+v"(c), "+v"(d), "+v"(e), "+v"(f), "+v"(g), "+v"(h) :: "memory")
#define WAIT_LOADS4(a, b, c, d) asm volatile("s_waitcnt vmcnt(0)" : "+v"(a), "+v"(b), "+v"(c), "+v"(d) :: "memory")
DI int crow(int reg, int h) { return (reg & 3) + 8 * (reg >> 2) + 4 * h; }
DI float silu_f(float v) { return v * __builtin_amdgcn_rcpf(1.f + __builtin_amdgcn_exp2f(-1.4426950408889634f * v)); }
DI float lam_init_f(int l) { return 0.8f - 0.6f * expf(-0.3f * (float)l); }

DI const float* src_row(const Params& p, int l, int b, int t) {
    if (l == 0) return t < SEQ ? p.x + ((size_t)b * SEQ + t) * D : p.ctx + ((size_t)b * CTXL + (t - SEQ)) * D;
    return t < SEQ ? p.out + ((size_t)b * SEQ + t) * D : p.xctx + ((size_t)b * CTXL + (t - SEQ)) * D;
}
DI float* dst_row(const Params& p, int b, int t) {
    return t < SEQ ? p.out + ((size_t)b * SEQ + t) * D : p.xctx + ((size_t)b * CTXL + (t - SEQ)) * D;
}

DI void transpose_item(const float* __restrict__ src, bf16_t* __restrict__ dst, int K, int N, int kt, int nt, char* smem) {
    float* tile = (float*)smem;
    const int tid = otid();
#pragma unroll
    for (int i = 0; i < 4; ++i) {
        const int c = tid + 256 * i, r = c >> 4, cc = c & 15;
        const float4 v = *(const float4*)(src + (size_t)(kt * 64 + r) * N + nt * 64 + cc * 4);
        tile[r * 65 + cc * 4 + 0] = v.x; tile[r * 65 + cc * 4 + 1] = v.y; tile[r * 65 + cc * 4 + 2] = v.z; tile[r * 65 + cc * 4 + 3] = v.w;
    }
    __syncthreads();
#pragma unroll
    for (int i = 0; i < 2; ++i) {
        const int c = tid + 256 * i, n = c >> 3, kc = c & 7;
        float f[8];
#pragma unroll
        for (int j = 0; j < 8; ++j) f[j] = tile[(kc * 8 + j) * 65 + n];
        uint4 o; o.x = pk2(f[0], f[1]); o.y = pk2(f[2], f[3]); o.z = pk2(f[4], f[5]); o.w = pk2(f[6], f[7]);
        *(uint4*)(dst + ((size_t)(2 * kt + (kc >> 2)) * N + nt * 64 + n) * 32 + (kc & 3) * 8) = o;
    }
    __syncthreads();
}

DI void adaln_item(const Params& p, int item, char* smem) {
    float* sc = (float*)smem;
    float* red = sc + 9 * 1024;
    const int tid = otid();
    const int l = item / 96, col0 = (item % 96) * 32;
    for (int i = tid; i < 9 * 1024; i += 256) {
        const int r = i >> 10, k = i & 1023;
        const float v = r < 8 ? p.c[r * 1024 + k] : p.c_ctx[k];
        sc[i] = v / (1.f + expf(-v));
    }
    __syncthreads();
    const int col = tid & 31, kg = tid >> 5;
    float acc[9];
#pragma unroll
    for (int r = 0; r < 9; ++r) acc[r] = 0.f;
    const float* w = p.w_ada + ((size_t)l * 1024 + kg * 128) * 3072 + col0 + col;
#pragma unroll 8
    for (int k = 0; k < 128; ++k) {
        const float wv = w[(size_t)k * 3072];
#pragma unroll
        for (int r = 0; r < 9; ++r) acc[r] += sc[r * 1024 + kg * 128 + k] * wv;
    }
#pragma unroll
    for (int r = 0; r < 9; ++r) red[(kg * 9 + r) * 32 + col] = acc[r];
    __syncthreads();
    for (int i = tid; i < 9 * 32; i += 256) {
        const int r = i >> 5, cc = i & 31;
        float s = 0.f;
#pragma unroll
        for (int g = 0; g < 8; ++g) s += red[(g * 9 + r) * 32 + cc];
        p.mod[((size_t)l * 9 + r) * 3072 + col0 + cc] = s + p.b_ada[l * 3072 + col0 + cc];
    }
    __syncthreads();
}

DI void prologue_phase(const Params& p, char* smem) {
    const int nb = gridDim.x, bid = blockIdx.x, tid = otid();
    constexpr int N_ADA = DEPTH * 96, N_TIN = DEPTH * 16 * 56, N_TOUT = DEPTH * 16 * 16;
    for (int it = bid; it < N_ADA + N_TIN + N_TOUT; it += nb) {
        if (it < N_ADA) adaln_item(p, it, smem);
        else if (it < N_ADA + N_TIN) {
            const int j = it - N_ADA, l = j / (16 * 56), r = j % (16 * 56), kt = r / 56, nt = r % 56;
            transpose_item(p.w_in + (size_t)l * D * INW, p.wtin + (size_t)l * INW * D, D, INW, kt, nt, smem);
        } else {
            const int j = it - N_ADA - N_TIN, l = j / 256, r = j % 256, kt = r / 16, nt = r % 16;
            transpose_item(p.w_out + (size_t)l * D * D, p.wtout + (size_t)l * D * D, D, D, kt, nt, smem);
        }
    }
    const int gtid = bid * NTHREADS + tid, gn = nb * NTHREADS;
    const float l2t = 13.287712379549449f;
    for (int i = gtid; i < SEQ * 32; i += gn) {
        const int t = i >> 5, k = i & 31;
        const float pos = (k < 16) ? (float)(t >> 6) : (float)(t & 63);
        const float inv = exp2f(-(float)(k & 15) * (1.f / 16.f) * l2t);
        const float ang = pos * inv;
        p.rope64[2 * (k * SEQ + t)] = cosf(ang); p.rope64[2 * (k * SEQ + t) + 1] = sinf(ang);
    }
    for (int i = gtid; i < SEQ * 16; i += gn) {
        const int t = i >> 4, k = i & 15;
        const float pos = (k < 8) ? (float)(t >> 6) : (float)(t & 63);
        const float inv = exp2f(-(float)(k & 7) * (1.f / 8.f) * l2t);
        const float ang = pos * inv;
        p.rope32[2 * (k * SEQ + t)] = cosf(ang); p.rope32[2 * (k * SEQ + t) + 1] = sinf(ang);
    }
    if (bid == 0 && tid < DEPTH) {
        const int l = tid;
        float s1 = 0.f, s2 = 0.f;
        for (int i = 0; i < 32; ++i) { s1 += p.lq1[l * 32 + i] * p.lk1[l * 32 + i]; s2 += p.lq2[l * 32 + i] * p.lk2[l * 32 + i]; }
        p.lam[l] = expf(s1) - expf(s2) + lam_init_f(l);
        p.lam[4 + l] = 1.f - lam_init_f(l);
        float a = 0.f, bq = 0.f, c = 0.f, d2 = 0.f, e2 = 0.f, f2 = 0.f, g = 0.f;
        for (int i = 0; i < 32; ++i) { a = fmaxf(a, fabsf(p.dqn[l * 32 + i])); bq = fmaxf(bq, fabsf(p.dkn[l * 32 + i])); }
        for (int i = 0; i < 64; ++i) { c = fmaxf(c, fabsf(p.gqn[l * 64 + i])); d2 = fmaxf(d2, fabsf(p.gkn[l * 64 + i])); e2 = fmaxf(e2, fabsf(p.nqn[l * 64 + i])); f2 = fmaxf(f2, fabsf(p.nkn[l * 64 + i])); }
        for (int i = 0; i < 6 * 465; ++i) g = fmaxf(g, fabsf(p.rpb[(size_t)l * 6 * 465 + i]));
        p.lam[8 + l * 4 + 0] = 5.656854249f * a * bq * LOG2E * 1.001f;
        p.lam[8 + l * 4 + 1] = 8.f * c * d2 * LOG2E * 1.001f;
        p.lam[8 + l * 4 + 2] = (8.f * e2 * f2 + g) * LOG2E * 1.001f;
        p.lam[8 + l * 4 + 3] = 8.f * e2 * f2 * LOG2E * 1.001f;
    }
}

DI void norm_phase(const Params& p, int l) {
    const int tid_ = otid(), lane = tid_ & 63, wave = tid_ >> 6;
    const int gw = blockIdx.x * 4 + wave, nw = gridDim.x * 4;
    const float* g = p.norm_g + l * D;
    float4 gg[4];
#pragma unroll
    for (int j = 0; j < 4; ++j) gg[j] = *(const float4*)(g + 256 * j + 4 * lane);
    for (int row0 = gw; row0 < NTOK; row0 += 3 * nw) {
        float4 v[3][4];
        const float* md[3];
#pragma unroll
        for (int u = 0; u < 3; ++u) {
            const int row = row0 + u * nw;
            const int rc = row < NTOK ? row : gw;
            const int b = rc / TPB, t = rc % TPB;
            const float* src = src_row(p, l, b, t);
            md[u] = p.mod + ((size_t)l * 9 + (t < SEQ ? b : 8)) * 3072;
#pragma unroll
            for (int j = 0; j < 4; ++j) v[u][j] = *(const float4*)(src + 256 * j + 4 * lane);
        }
#pragma unroll
        for (int u = 0; u < 3; ++u) {
            const int row = row0 + u * nw;
            float4 sh[4], sc[4];
#pragma unroll
            for (int j = 0; j < 4; ++j) { sh[j] = *(const float4*)(md[u] + 256 * j + 4 * lane); sc[j] = *(const float4*)(md[u] + 1024 + 256 * j + 4 * lane); }
            float ss = 0.f;
#pragma unroll
            for (int j = 0; j < 4; ++j) ss += v[u][j].x * v[u][j].x + v[u][j].y * v[u][j].y + v[u][j].z * v[u][j].z + v[u][j].w * v[u][j].w;
#pragma unroll
            for (int o = 1; o < 64; o <<= 1) ss += __shfl_xor(ss, o);
            const float rstd = rsqrtf(ss * (1.f / D) + EPS);
            if (row < NTOK) {
                bf16_t* dst = p.hmix + (size_t)row * 32;
#pragma unroll
                for (int j = 0; j < 4; ++j) {
                    const int k = 256 * j + 4 * lane;
                    const float o0 = (v[u][j].x * rstd * gg[j].x) * (1.f + sc[j].x) + sh[j].x;
                    const float o1 = (v[u][j].y * rstd * gg[j].y) * (1.f + sc[j].y) + sh[j].y;
                    const float o2 = (v[u][j].z * rstd * gg[j].z) * (1.f + sc[j].z) + sh[j].z;
                    const float o3 = (v[u][j].w * rstd * gg[j].w) * (1.f + sc[j].w) + sh[j].w;
                    uint2 o; o.x = pk2(o0, o1); o.y = pk2(o2, o3);
                    *(uint2*)(dst + (size_t)(k >> 5) * NTOK * 32 + (k & 31)) = o;
                }
            }
        }
    }
}

typedef __attribute__((address_space(3))) unsigned lds_u32;
DI void dma16(const void* g, char* l) { __builtin_amdgcn_global_load_lds((const unsigned*)g, (lds_u32*)l, 16, 0, 0); }
template <bool VMODE, int TJ>
DI void gemm_mainloop(const bf16_t* __restrict__ W, const bf16_t* __restrict__ X, int NW, char* smem, f32x16 (&acc)[2][TJ]) {
    constexpr int XROWS = 64 * TJ, STAGE = (128 + XROWS) * 64, NPW = 2 + TJ;
    const int tid = otid(), lane = tid & 63, wave = tid >> 6, r = lane & 31, h = lane >> 5, wf = wave & 1, wt = wave >> 1;
    const int goff = (16 * wave + (lane >> 2)) * 32 + (((lane & 3) ^ (lane >> 4)) << 3);
    const bf16_t* wp = W + goff;
    const bf16_t* xp = X + goff;
    const size_t wks = (size_t)NW * 32, xks = (size_t)NTOK * 32;
    char* ld = smem + tid * 16;
#define G_ISSUE(ks_, buf_) do { \
    const bf16_t* wq_ = wp + (ks_) * wks; const bf16_t* xq_ = xp + (ks_) * xks; char* lb_ = ld + (buf_) * STAGE; \
    dma16(wq_, lb_); dma16(wq_ + 2048, lb_ + 4096); \
    _Pragma("unroll") for (int i_ = 0; i_ < TJ; ++i_) dma16(xq_ + i_ * 2048, lb_ + 8192 + i_ * 4096); } while (0)
    const int xr = (r >> 2) & 3;
    const int fo0 = r * 64 + (((0 + h) ^ xr) << 4), fo1 = r * 64 + (((2 + h) ^ xr) << 4);
    __syncthreads();
#define G_COMPUTE(slot_) do { \
        const char* sw = smem + (slot_) * STAGE + wf * 64 * 64; \
        const char* sx = smem + (slot_) * STAGE + 8192 + wt * (32 * TJ) * 64; \
        _Pragma("unroll") for (int s = 0; s < 2; ++s) { \
            const int fo = (s == 0) ? fo0 : fo1; \
            bf16x8 fw[2], fx[TJ]; \
            _Pragma("unroll") for (int i = 0; i < 2; ++i) fw[i] = *(const bf16x8*)(sw + i * 32 * 64 + fo); \
            _Pragma("unroll") for (int j = 0; j < TJ; ++j) fx[j] = *(const bf16x8*)(sx + j * 32 * 64 + fo); \
            _Pragma("unroll") for (int i = 0; i < 2; ++i) \
                _Pragma("unroll") for (int j = 0; j < TJ; ++j) \
                    acc[i][j] = VMODE ? MFMA(fx[j], fw[i], acc[i][j]) : MFMA(fw[i], fx[j], acc[i][j]); \
        } } while (0)
    if (TJ == 2) {
        G_ISSUE(0, 0);
        G_ISSUE(1, 1);
        for (int kp = 0; kp < 16; ++kp) {
            asm volatile("s_waitcnt vmcnt(0)" ::: "memory");
            __builtin_amdgcn_s_barrier();
            const int sl = (kp & 1) * 2;
            {
                const char* sw = smem + sl * STAGE + wf * 64 * 64;
                const char* sx = smem + sl * STAGE + 8192 + wt * (32 * TJ) * 64;
                bf16x8 fw[2], fx[TJ];
#pragma unroll
                for (int i = 0; i < 2; ++i) fw[i] = *(const bf16x8*)(sw + i * 32 * 64 + fo0);
#pragma unroll
                for (int j = 0; j < TJ; ++j) fx[j] = *(const bf16x8*)(sx + j * 32 * 64 + fo0);
                __builtin_amdgcn_sched_barrier(0);
                if (kp + 1 < 16) { G_ISSUE(2 * kp + 2, 2 - sl); G_ISSUE(2 * kp + 3, 3 - sl); }
                __builtin_amdgcn_sched_barrier(0);
#pragma unroll
                for (int i = 0; i < 2; ++i)
#pragma unroll
                    for (int j = 0; j < TJ; ++j) acc[i][j] = VMODE ? MFMA(fx[j], fw[i], acc[i][j]) : MFMA(fw[i], fx[j], acc[i][j]);
#pragma unroll
                for (int i = 0; i < 2; ++i) fw[i] = *(const bf16x8*)(sw + i * 32 * 64 + fo1);
#pragma unroll
                for (int j = 0; j < TJ; ++j) fx[j] = *(const bf16x8*)(sx + j * 32 * 64 + fo1);
#pragma unroll
                for (int i = 0; i < 2; ++i)
#pragma unroll
                    for (int j = 0; j < TJ; ++j) acc[i][j] = VMODE ? MFMA(fx[j], fw[i], acc[i][j]) : MFMA(fw[i], fx[j], acc[i][j]);
            }
            G_COMPUTE(sl + 1);
        }
    } else {
        G_ISSUE(0, 0);
        G_ISSUE(1, 1);
        int bc = 0, bn = 2;
        for (int ks = 0; ks < 32; ++ks) {
            if (ks < 31) asm volatile("s_waitcnt vmcnt(6)" ::: "memory");
            else asm volatile("s_waitcnt vmcnt(0)" ::: "memory");
            __builtin_amdgcn_s_barrier();
            const char* sw = smem + bc * STAGE + wf * 64 * 64;
            const char* sx = smem + bc * STAGE + 8192 + wt * (32 * TJ) * 64;
            bf16x8 fw[2], fx[TJ], gw[2], gx[TJ];
#pragma unroll
            for (int i = 0; i < 2; ++i) fw[i] = *(const bf16x8*)(sw + i * 32 * 64 + fo0);
#pragma unroll
            for (int j = 0; j < TJ; ++j) fx[j] = *(const bf16x8*)(sx + j * 32 * 64 + fo0);
            __builtin_amdgcn_sched_barrier(0);
            if (ks + 2 < 32) G_ISSUE(ks + 2, bn);
            __builtin_amdgcn_sched_barrier(0);
#pragma unroll
            for (int i = 0; i < 2; ++i) gw[i] = *(const bf16x8*)(sw + i * 32 * 64 + fo1);
#pragma unroll
            for (int j = 0; j < TJ; ++j) gx[j] = *(const bf16x8*)(sx + j * 32 * 64 + fo1);
#pragma unroll
            for (int i = 0; i < 2; ++i)
#pragma unroll
                for (int j = 0; j < TJ; ++j) acc[i][j] = VMODE ? MFMA(fx[j], fw[i], acc[i][j]) : MFMA(fw[i], fx[j], acc[i][j]);
#pragma unroll
            for (int i = 0; i < 2; ++i)
#pragma unroll
                for (int j = 0; j < TJ; ++j) acc[i][j] = VMODE ? MFMA(gx[j], gw[i], acc[i][j]) : MFMA(gw[i], gx[j], acc[i][j]);
            bc = (bc == 2) ? 0 : bc + 1; bn = (bn == 2) ? 0 : bn + 1;
        }
    }
#undef G_COMPUTE
    __syncthreads();
#undef G_ISSUE
}

template <int TJ>
DI void zero_acc(f32x16 (&acc)[2][TJ]) {
#pragma unroll
    for (int i = 0; i < 2; ++i)
#pragma unroll
        for (int j = 0; j < TJ; ++j)
#pragma unroll
            for (int e = 0; e < 16; ++e) acc[i][j][e] = 0.f;
}

DI void stage_quad_bf16(char* sb, int row, int c16, int half, uint2 v) { *(uint2*)(sb + row * 128 + ((c16 ^ (row & 7)) << 4) + (half << 3)) = v; }
template <int NIT>
DI void stage_flush_bf16(const char* sb, bf16_t* gdst, int lane) {
#pragma unroll
    for (int it = 0; it < NIT; ++it) {
        const int c = lane + 64 * it, row = c >> 3, lc = (c & 7) ^ (row & 7);
        const u32x4_t v = *(const u32x4_t*)(sb + c * 16);
        *(u32x4_t*)(gdst + row * 64 + lc * 8) = v;
    }
}
DI void store_tile_bf16(bf16_t* orow, const f32x16& a, int h) {
#pragma unroll
    for (int q = 0; q < 4; ++q) {
        uint2 o; o.x = pk2(a[4 * q], a[4 * q + 1]); o.y = pk2(a[4 * q + 2], a[4 * q + 3]);
        *(uint2*)(orow + 8 * q + 4 * h) = o;
    }
}

DI void epi_inproj(const Params& p, int l, int mtile, int n0, f32x16 (&acc)[2][4], char* smem) {
    const int tid = otid(), lane = tid & 63, wave = tid >> 6, r = lane & 31, h = lane >> 5, wf = wave & 1, wt = wave >> 1;
    char* sb = smem + wave * 16384;
    const int b = mtile / 9, tt = mtile % 9, t0 = tt * 256;
    const bool latent = tt < 8;
    const int nw = n0 + 64 * wf;
    int type; const float* nwt = nullptr; bool rope = false;
    if (n0 < 256) { type = 2; nwt = p.dqn + l * 32; rope = true; }
    else if (n0 < 512) { type = 2; nwt = p.dkn + l * 32; rope = true; }
    else if (n0 < 1024) { type = 1; }
    else if (n0 < 1408) { type = 3; nwt = p.gqn + l * 64; rope = true; }
    else if (n0 < 1536) { type = 3; nwt = p.gkn + l * 64; rope = true; }
    else if (n0 < 2048) { type = 1; }
    else if (n0 < 2432) { type = 3; nwt = p.nqn + l * 64; }
    else if (n0 < 2816) { type = 3; nwt = p.nkn + l * 64; }
    else { type = 1; }
    rope = rope && latent;
    const float qs = (n0 < 256) ? 0.17677669529663687f * LOG2E : ((n0 >= 1024 && n0 < 1408) || (n0 >= 2048 && n0 < 2432)) ? 0.125f * LOG2E : 1.f;
#pragma unroll
    for (int j = 0; j < 4; ++j) {
        const int t = t0 + 128 * wt + 32 * j + r;
        if (type == 1) {
#pragma unroll
            for (int i = 0; i < 2; ++i) {
#pragma unroll
                for (int e = 0; e < 16; ++e) acc[i][j][e] = silu_f(acc[i][j][e]);
            }
        } else if (type == 3) {
            float ss = 0.f;
#pragma unroll
            for (int i = 0; i < 2; ++i)
#pragma unroll
                for (int e = 0; e < 16; ++e) ss += acc[i][j][e] * acc[i][j][e];
            ss += __shfl_xor(ss, 32);
            const float rstd = rsqrtf(ss * (1.f / 64.f) + EPS) * qs;
#pragma unroll
            for (int i = 0; i < 2; ++i)
#pragma unroll
                for (int q = 0; q < 4; ++q) {
                    const float4 w4 = *(const float4*)(nwt + 32 * i + 8 * q + 4 * h);
                    acc[i][j][4 * q + 0] *= rstd * w4.x; acc[i][j][4 * q + 1] *= rstd * w4.y;
                    acc[i][j][4 * q + 2] *= rstd * w4.z; acc[i][j][4 * q + 3] *= rstd * w4.w;
                }
            if (rope) {
                const float* tab = p.rope64 + (size_t)t * 2;
#pragma unroll
                for (int q = 0; q < 4; ++q) {
#pragma unroll
                    for (int e = 0; e < 4; ++e) {
                        const float2 cs = *(const float2*)(tab + (size_t)(8 * q + 4 * h + e) * (SEQ * 2));
                        const float x1 = acc[0][j][4 * q + e], x2 = acc[1][j][4 * q + e];
                        acc[0][j][4 * q + e] = x1 * cs.x - x2 * cs.y;
                        acc[1][j][4 * q + e] = x2 * cs.x + x1 * cs.y;
                    }
                }
            }
        } else {
#pragma unroll
            for (int i = 0; i < 2; ++i) {
                float ss = 0.f;
#pragma unroll
                for (int e = 0; e < 16; ++e) ss += acc[i][j][e] * acc[i][j][e];
                ss += __shfl_xor(ss, 32);
                const float rstd = rsqrtf(ss * (1.f / 32.f) + EPS) * qs;
#pragma unroll
                for (int q = 0; q < 4; ++q) {
                    const float4 w4 = *(const float4*)(nwt + 8 * q + 4 * h);
                    acc[i][j][4 * q + 0] *= rstd * w4.x; acc[i][j][4 * q + 1] *= rstd * w4.y;
                    acc[i][j][4 * q + 2] *= rstd * w4.z; acc[i][j][4 * q + 3] *= rstd * w4.w;
                }
                if (rope) {
                    const float* tab = p.rope32 + (size_t)t * 2;
#pragma unroll
                    for (int q = 0; q < 2; ++q) {
#pragma unroll
                        for (int e = 0; e < 4; ++e) {
                            const float2 cs = *(const float2*)(tab + (size_t)(8 * q + 4 * h + e) * (SEQ * 2));
                            const float x1 = acc[i][j][4 * q + e], x2 = acc[i][j][4 * q + 8 + e];
                            acc[i][j][4 * q + e] = x1 * cs.x - x2 * cs.y;
                            acc[i][j][4 * q + 8 + e] = x2 * cs.x + x1 * cs.y;
                        }
                    }
                }
            }
        }
#pragma unroll
        for (int i = 0; i < 2; ++i)
#pragma unroll
            for (int q = 0; q < 4; ++q) {
                uint2 o; o.x = pk2(acc[i][j][4 * q], acc[i][j][4 * q + 1]); o.y = pk2(acc[i][j][4 * q + 2], acc[i][j][4 * q + 3]);
                stage_quad_bf16(sb, 32 * j + r, 4 * i + q, h, o);
            }
    }
    stage_flush_bf16<16>(sb, p.qkv + ((size_t)(nw >> 6) * NTOK + (size_t)b * TPB + t0 + 128 * wt) * 64, lane);
}

DI void epi_v(const Params& p, int mtile, int vf0, f32x16 (&acc)[2][4], char* smem) {
    const int tid = otid(), lane = tid & 63, wave = tid >> 6, r = lane & 31, h = lane >> 5, wf = wave & 1, wt = wave >> 1;
    const int b = mtile / 9, t0 = (mtile % 9) * 256;
    char* sb = smem + wave * 16384;
#pragma unroll
    for (int i = 0; i < 2; ++i)
#pragma unroll
        for (int j = 0; j < 4; ++j)
#pragma unroll
            for (int q = 0; q < 4; ++q) {
                uint2 o; o.x = pk2(acc[i][j][4 * q], acc[i][j][4 * q + 1]); o.y = pk2(acc[i][j][4 * q + 2], acc[i][j][4 * q + 3]);
                stage_quad_bf16(sb + (j >> 1) * 8192, 32 * i + r, 4 * (j & 1) + 2 * (q >> 1) + h, q & 1, o);
            }
    bf16_t* g0 = p.vT + (((size_t)b * 12 + (vf0 >> 6) + wf) * 36 + (t0 >> 6) + 2 * wt) * 4096;
    stage_flush_bf16<8>(sb, g0, lane);
    stage_flush_bf16<8>(sb + 8192, g0 + 4096, lane);
}

DI void inproj_phase(const Params& p, int l, char* smem) {
    constexpr int NT = 28, MT = NTOK / 256;
    const bool xmap = gridDim.x == 512;
    const int xcd = blockIdx.x & 7, xj = blockIdx.x >> 3;
    for (int it = 0;; ++it) {
        int mtile, nt;
        if (xmap) {
            if (it >= 4 || xj >= 63) break;
            mtile = 9 * xcd + (xj % 9); nt = 7 * it + (xj / 9);
        } else {
            const int tile = blockIdx.x + it * gridDim.x;
            if (tile >= MT * NT) break;
            mtile = tile / NT; nt = tile % NT;
        }
        const int n0 = nt * 128;
        const bf16_t* W = p.wtin + (size_t)l * INW * D + (size_t)n0 * 32;
        const bf16_t* X = p.hmix + (size_t)mtile * 256 * 32;
        f32x16 acc[2][4];
        zero_acc<4>(acc);
        int vf0 = -1;
        if (n0 >= 512 && n0 < 768) vf0 = n0 - 512;
        else if (n0 >= 1536 && n0 < 1664) vf0 = 256 + (n0 - 1536);
        else if (n0 >= 2816 && n0 < 3200) vf0 = 384 + (n0 - 2816);
        if (vf0 >= 0) { gemm_mainloop<true, 4>(W, X, INW, smem, acc); epi_v(p, mtile, vf0, acc, smem); }
        else { gemm_mainloop<false, 4>(W, X, INW, smem, acc); epi_inproj(p, l, mtile, n0, acc, smem); }
    }
}

DI void outproj_phase(const Params& p, int l, char* smem) {
    constexpr int NT = 8, MT = NTOK / 128;
    const int tid = otid(), lane = tid & 63, wave = tid >> 6, r = lane & 31, h = lane >> 5, wf = wave & 1, wt = wave >> 1;
    const bool xmap = gridDim.x == 512;
    const int xcd = blockIdx.x & 7, xj = blockIdx.x >> 3;
    const int mper = (l == DEPTH - 1) ? 16 : 18;
    for (int it = 0;; ++it) {
        int mtile, nt;
        if (xmap) {
            const int idx = it * 64 + xj;
            if (idx >= mper * 8) break;
            mtile = 18 * xcd + (idx >> 3); nt = idx & 7;
        } else {
            const int tile = blockIdx.x + it * gridDim.x;
            if (tile >= MT * NT) break;
            mtile = tile / NT; nt = tile % NT;
            if (l == DEPTH - 1 && (mtile % 18) >= 16) continue;
        }
        const int n0 = nt * 128;
        const int b = mtile / 18, tt = mtile % 18, t0 = tt * 128;
        const bf16_t* W = p.wtout + (size_t)l * D * D + (size_t)n0 * 32;
        const bf16_t* X = p.hmix + (size_t)mtile * 128 * 32;
        f32x16 acc[2][2];
        zero_acc<2>(acc);
        gemm_mainloop<false, 2>(W, X, D, smem, acc);
        if (DBL & 8) { zero_acc<2>(acc); gemm_mainloop<false, 2>(W, X, D, smem, acc); }
        const float* gt = p.mod + ((size_t)l * 9 + (tt < 16 ? b : 8)) * 3072 + 2048 + n0 + 64 * wf;
        const float* xs = src_row(p, l, b, t0 + 64 * wt) + n0 + 64 * wf;
        float* xd = dst_row(p, b, t0 + 64 * wt) + n0 + 64 * wf;
        char* sb = smem + wave * 8192;
        float4 xo[2][8];
#pragma unroll
        for (int i = 0; i < 2; ++i)
#pragma unroll
            for (int it = 0; it < 8; ++it) {
                const int c = lane + 64 * it, row = c >> 3, f = 32 * i + 4 * ((c & 7) ^ (row & 7));
                xo[i][it] = *(const float4*)(xs + (size_t)row * D + f);
            }
#pragma unroll
        for (int i = 0; i < 2; ++i) {
#pragma unroll
            for (int j = 0; j < 2; ++j)
#pragma unroll
                for (int q = 0; q < 4; ++q) {
                    const int row = 32 * j + r, c16 = 2 * q + h;
                    float4 y; y.x = acc[i][j][4 * q]; y.y = acc[i][j][4 * q + 1]; y.z = acc[i][j][4 * q + 2]; y.w = acc[i][j][4 * q + 3];
                    *(float4*)(sb + row * 128 + ((c16 ^ (row & 7)) << 4)) = y;
                }
#pragma unroll
            for (int it = 0; it < 8; ++it) {
                const int c = lane + 64 * it, row = c >> 3, f = 32 * i + 4 * ((c & 7) ^ (row & 7));
                const float4 y = *(const float4*)(sb + c * 16);
                const float4 g4 = *(const float4*)(gt + f);
                float4 o;
                o.x = xo[i][it].x + g4.x * y.x; o.y = xo[i][it].y + g4.y * y.y; o.z = xo[i][it].z + g4.z * y.z; o.w = xo[i][it].w + g4.w * y.w;
                *(float4*)(xd + (size_t)row * D + f) = o;
            }
        }
    }
}

constexpr int ATT_SLOT = 16384, ATT_V = 8192, ATT_BIAS = 49152;
#define KV_ISSUE(tile_, slot_) do { \
    const bf16_t* kp_ = kbase + (size_t)(tile_) * 4096 + kvoff; const bf16_t* vp_ = vbase + (size_t)(tile_) * 4096 + kvoff; \
    char* lp_ = smem + (slot_) * ATT_SLOT + tid * 16; \
    dma16(kp_, lp_); dma16(kp_ + 2048, lp_ + 4096); dma16(vp_, lp_ + ATT_V); dma16(vp_ + 2048, lp_ + ATT_V + 4096); } while (0)

DI bf16x8 pack8(const f32x16& x, int s) {
    union { unsigned u[4]; bf16x8 v; } o;
    o.u[0] = pk2(x[8 * s + 0], x[8 * s + 1]); o.u[1] = pk2(x[8 * s + 2], x[8 * s + 3]);
    o.u[2] = pk2(x[8 * s + 4], x[8 * s + 5]); o.u[3] = pk2(x[8 * s + 6], x[8 * s + 7]);
    return o.v;
}
DI bf16x8 ldv_frag(const char* sv, int drow, int c, int xr) {
    return *(const bf16x8*)(sv + drow * 128 + ((c ^ xr) << 4));
}

DI void softmax_tile(f32x16 (&S)[2], float& lsum) {
    f2_t ps = {0.f, 0.f};
#pragma unroll
    for (int t = 0; t < 2; ++t)
#pragma unroll
        for (int e = 0; e < 16; e += 2) {
            f2_t pv; pv.x = __builtin_amdgcn_exp2f(S[t][e]); pv.y = __builtin_amdgcn_exp2f(S[t][e + 1]);
            S[t][e] = pv.x; S[t][e + 1] = pv.y;
            ps += pv;
        }
    lsum += ps.x + ps.y;
}
DI void pv_tile(const f32x16 (&S)[2], f32x16 (&O)[2], const bf16x8 (&vf)[8]) {
#pragma unroll
    for (int s = 0; s < 4; ++s) {
        const bf16x8 pf = pack8(S[s >> 1], s & 1);
#pragma unroll
        for (int dt = 0; dt < 2; ++dt) O[dt] = MFMA(vf[2 * s + dt], pf, O[dt]);
    }
}

template <int KIND>
DI void attn_unit(const Params& p, int l, int b, int head, int qt, int qcol, int kcol, int vfeat, int gcol, int mixcol,
                  int t1, int n1, int t2, int n2, char* smem) {
    const int tid = otid(), lane = tid & 63, wave = tid >> 6, r = lane & 31, h = lane >> 5;
    const int tq = qt * 128 + 32 * wave + r;
    const size_t qrow = (size_t)b * TPB + tq;
    const bf16_t* kbase = p.qkv + ((size_t)(kcol >> 6) * NTOK + (size_t)b * TPB) * 64;
    const bf16_t* vbase = p.vT + ((size_t)b * 12 + (vfeat >> 6)) * 36 * 4096;
    const int nt = n1 + n2;

    bf16x8 qf[4];
    {
        const bf16_t* qp = p.qkv + ((size_t)(qcol >> 6) * NTOK + qrow) * 64 + 8 * h;
#pragma unroll
        for (int s = 0; s < 4; ++s) qf[s] = *(const bf16x8*)(qp + 16 * s);
    }
    int nrow = 0, r0w = 0, qc = 0, c0 = 0;
    if (KIND == 2) {
        nrow = 2 * qt + (wave >> 1); r0w = min(max(nrow - 4, 0), 24);
        qc = 32 * (wave & 1) + r; c0 = min(max(qc - 8, 0), 48);
        float* bias = (float*)(smem + ATT_BIAS);
        for (int i = tid; i < 15 * 32; i += NTHREADS) { const int rr = i >> 5, cc = i & 31; bias[i] = cc < 31 ? p.rpb[((size_t)l * 6 + head) * 465 + rr * 31 + cc] * LOG2E : -INFINITY; }
    }
    int bcol[2][16];
    if (KIND == 2) {
#pragma unroll
        for (int t = 0; t < 2; ++t)
#pragma unroll
            for (int e = 0; e < 16; ++e) {
                const int kc = 32 * t + crow(e, h);
                bcol[t][e] = ((unsigned)(kc - c0) < 16u) ? (kc - qc + 15) * 4 : 31 * 4;
            }
    }
    f32x16 O0[2], O1[2];
#pragma unroll
    for (int t = 0; t < 2; ++t)
#pragma unroll
        for (int e = 0; e < 16; ++e) { O0[t][e] = 0.f; O1[t][e] = 0.f; }
    float l0 = 0.f, l1 = 0.f;
    const float zb = p.lam[8 + l * 4 + ((KIND == 1 && qcol >= 2048) ? 3 : KIND)];
    f32x16 cz;
#pragma unroll
    for (int e = 0; e < 16; ++e) cz[e] = -zb;

    const int kvoff = (8 * wave + (lane >> 3)) * 64 + (((lane & 7) ^ (((wave & 1) << 2) | (lane >> 4))) << 3);
    const int xr = (r >> 1) & 7;
    __syncthreads();
    KV_ISSUE(t1, 0);
    if (nt > 1) KV_ISSUE((1 < n1) ? t1 + 1 : t2 + (1 - n1), 1);
    int sc = 0, sn = 2;
    for (int it = 0; it < nt; ++it) {
        const int tile = (it < n1) ? t1 + it : t2 + (it - n1);
        if (it + 1 < nt) asm volatile("s_waitcnt vmcnt(4)" ::: "memory"); else asm volatile("s_waitcnt vmcnt(0)" ::: "memory");
        __builtin_amdgcn_s_barrier();
        const char* sk = smem + sc * ATT_SLOT;
        const char* sv = sk + ATT_V;
        bool active = true;
        if (KIND == 2 && tile < 32) active = (tile >= r0w) && (tile < r0w + 8);
        bf16x8 kf[8], vf[8];
        if (active) {
#pragma unroll
            for (int s = 0; s < 4; ++s)
#pragma unroll
                for (int t = 0; t < 2; ++t) kf[2 * s + t] = *(const bf16x8*)(sk + (32 * t + r) * 128 + (((2 * s + h) ^ xr) << 4));
        }
        __builtin_amdgcn_sched_barrier(0);
        if (it + 2 < nt) { const int nx = (it + 2 < n1) ? t1 + it + 2 : t2 + (it + 2 - n1); KV_ISSUE(nx, sn); }
        sc = (sc == 2) ? 0 : sc + 1; sn = (sn == 2) ? 0 : sn + 1;
        __builtin_amdgcn_sched_barrier(0);
        if (active) {
#define LOAD_VF() do { \
            __builtin_amdgcn_sched_barrier(0); \
            _Pragma("unroll") for (int s = 0; s < 4; ++s) \
                _Pragma("unroll") for (int dt = 0; dt < 2; ++dt) vf[2 * s + dt] = ldv_frag(sv, 32 * dt + r, 2 * s + h, xr); \
            __builtin_amdgcn_sched_barrier(0); } while (0)
            if (KIND == 0) {
                f32x16 S0[2], S1[2];
#pragma unroll
                for (int t = 0; t < 2; ++t) { S0[t] = MFMA(kf[t], qf[0], cz); S1[t] = MFMA(kf[4 + t], qf[2], cz); }
#pragma unroll
                for (int t = 0; t < 2; ++t) { S0[t] = MFMA(kf[2 + t], qf[1], S0[t]); S1[t] = MFMA(kf[6 + t], qf[3], S1[t]); }
                LOAD_VF();
                softmax_tile(S0, l0);
                pv_tile(S0, O0, vf);
                softmax_tile(S1, l1);
                pv_tile(S1, O1, vf);
            } else {
                f32x16 S[2];
#pragma unroll
                for (int t = 0; t < 2; ++t) S[t] = MFMA(kf[t], qf[0], cz);
#pragma unroll
                for (int s = 1; s < 4; ++s)
#pragma unroll
                    for (int t = 0; t < 2; ++t) S[t] = MFMA(kf[2 * s + t], qf[s], S[t]);
                LOAD_VF();
                if (KIND == 2 && tile < 32) {
                    const char* brow = smem + ATT_BIAS + (tile - nrow + 7) * 128;
#pragma unroll
                    for (int t = 0; t < 2; ++t)
#pragma unroll
                        for (int e = 0; e < 16; ++e) S[t][e] += *(const float*)(brow + bcol[t][e]);
                }
                softmax_tile(S, l0);
                pv_tile(S, O0, vf);
            }
#undef LOAD_VF
        }
    }
    l0 += __shfl_xor(l0, 32);
    const float inv0 = 1.f / l0;
    const int tid_e = otid();
    const size_t qrow_e = (size_t)b * TPB + qt * 128 + 32 * (tid_e >> 6) + (tid_e & 31);
    bf16_t* orow = p.hmix + ((size_t)(mixcol >> 5) * NTOK + qrow_e) * 32;
    const bf16_t* grow = p.qkv + ((size_t)(gcol >> 6) * NTOK + qrow_e) * 64;
    if (KIND == 0) {
        l1 += __shfl_xor(l1, 32);
        const float lam = p.lam[l];
        const float inv1 = lam / l1;
        float ss = 0.f;
#pragma unroll
        for (int t = 0; t < 2; ++t)
#pragma unroll
            for (int e = 0; e < 16; ++e) { const float o = O0[t][e] * inv0 - O1[t][e] * inv1; O0[t][e] = o; ss += o * o; }
        ss += __shfl_xor(ss, 32);
        const float rstd = rsqrtf(ss * (1.f / 64.f) + EPS) * p.lam[4 + l];
        const float* sw = p.subln + l * 64;
#pragma unroll
        for (int t = 0; t < 2; ++t)
#pragma unroll
            for (int q = 0; q < 4; ++q) {
                const int f = 32 * t + 8 * q + 4 * h;
                const float4 w4 = *(const float4*)(sw + f);
                const uint2 gg = *(const uint2*)(grow + f);
                const float g0 = bf2f((bf16_t)(gg.x & 0xffff)), g1 = bf2f((bf16_t)(gg.x >> 16)), g2 = bf2f((bf16_t)(gg.y & 0xffff)), g3 = bf2f((bf16_t)(gg.y >> 16));
                uint2 o;
                o.x = pk2(O0[t][4 * q + 0] * rstd * w4.x * g0, O0[t][4 * q + 1] * rstd * w4.y * g1);
                o.y = pk2(O0[t][4 * q + 2] * rstd * w4.z * g2, O0[t][4 * q + 3] * rstd * w4.w * g3);
                *(uint2*)(orow + (size_t)t * NTOK * 32 + 8 * q + 4 * h) = o;
            }
    } else {
#pragma unroll
        for (int t = 0; t < 2; ++t)
#pragma unroll
            for (int q = 0; q < 4; ++q) {
                const int f = 32 * t + 8 * q + 4 * h;
                const uint2 gg = *(const uint2*)(grow + f);
                const float g0 = bf2f((bf16_t)(gg.x & 0xffff)), g1 = bf2f((bf16_t)(gg.x >> 16)), g2 = bf2f((bf16_t)(gg.y & 0xffff)), g3 = bf2f((bf16_t)(gg.y >> 16));
                uint2 o;
                o.x = pk2(O0[t][4 * q + 0] * inv0 * g0, O0[t][4 * q + 1] * inv0 * g1);
                o.y = pk2(O0[t][4 * q + 2] * inv0 * g2, O0[t][4 * q + 3] * inv0 * g3);
                *(uint2*)(orow + (size_t)t * NTOK * 32 + 8 * q + 4 * h) = o;
            }
    }
}

template <int Q>
DI void attn_queue(const Params& p, int l, char* smem, int* s_unit, int cb) {
    const bool ctxu = l < DEPTH - 1;
    const int total = (Q == 0) ? (ctxu ? 576 : 512) : (Q == 1) ? (ctxu ? 960 : 768) : 768;
    for (;;) {
        if (threadIdx.x == 0) *s_unit = (int)atomicAdd(p.ctr + cb + l * 4 + Q, 1u);
        __syncthreads();
        const int u = *s_unit;
        __syncthreads();
        if (u >= total) break;
        if (Q == 0) {
            int b, head, qt, t1 = 0, n1 = 36;
            if (u < 512) { b = u >> 6; head = (u >> 4) & 3; qt = u & 15; }
            else { const int v = u - 512; b = v >> 3; head = (v >> 1) & 3; qt = 16 + (v & 1); t1 = 32; n1 = 4; }
            attn_unit<0>(p, l, b, head, qt, head * 64, 256 + head * 64, head * 64, 768 + head * 64, head * 64, t1, n1, 0, 0, smem);
        } else if (Q == 1) {
            int b, head, qt, t1 = 0, n1 = 36; bool cgrp = false;
            if (u < 768) { b = u / 96; head = (u >> 4) % 6; qt = u & 15; }
            else if (u < 864) { const int v = u - 768; b = v / 12; head = (v >> 1) % 6; qt = 16 + (v & 1); t1 = 32; n1 = 4; }
            else { const int v = u - 864; b = v / 12; head = (v >> 1) % 6; qt = 16 + (v & 1); t1 = 32; n1 = 4; cgrp = true; }
            int qcol, kcol, vfeat, gcol, mixcol;
            if (!cgrp) { const int kv = head / 3; qcol = 1024 + head * 64; kcol = 1408 + kv * 64; vfeat = 256 + kv * 64; gcol = 1664 + head * 64; mixcol = 256 + head * 64; }
            else { qcol = 2048 + head * 64; kcol = 2432 + head * 64; vfeat = 384 + head * 64; gcol = 3200 + head * 64; mixcol = 640 + head * 64; }
            attn_unit<1>(p, l, b, head, qt, qcol, kcol, vfeat, gcol, mixcol, t1, n1, 0, 0, smem);
        } else {
            const int b = u / 96, head = (u >> 4) % 6, qt = u & 15;
            const int t1 = min(max(2 * qt - 4, 0), 24), n1 = min(max(2 * qt + 1 - 4, 0), 24) + 8 - t1;
            attn_unit<2>(p, l, b, head, qt, 2048 + head * 64, 2432 + head * 64, 384 + head * 64, 3200 + head * 64, 640 + head * 64, t1, n1, 32, 4, smem);
        }
    }
}
DI void attn_phase(const Params& p, int l, char* smem, int cb) {
    __shared__ int s_unit;
    attn_queue<0>(p, l, smem, &s_unit, cb);
    attn_queue<1>(p, l, smem, &s_unit, cb);
    attn_queue<2>(p, l, smem, &s_unit, cb);
}

#define XB_TMO      128
#define XB_XCNT(j)  (256  + 64 * (j))
#define XB_XSUB(j)  (1280 + 64 * (j))
#define XB_XGEN(j)  (2304 + 64 * (j))
#define XB_TOP      3328
#define XB_TOPGEN   3392
#define XCD_BAR_WORDS 3456
#define XB_SPIN_CAP (1u << 20)
#define LAS __attribute__((address_space(3)))
DI unsigned xb_ld(unsigned* p)              { return __hip_atomic_load(p, __ATOMIC_RELAXED, __HIP_MEMORY_SCOPE_AGENT); }
DI unsigned xb_add(unsigned* p, unsigned v) { return __hip_atomic_fetch_add(p, v, __ATOMIC_RELAXED, __HIP_MEMORY_SCOPE_AGENT); }
DI unsigned xb_xcc_id() { return (unsigned)__builtin_amdgcn_s_getreg((3 << 11) | 20) & 0xFu; }
#define XB_SPIN(cond, bar) do { unsigned _sp = 0; while (cond) { __builtin_amdgcn_s_sleep(1); \
    if ((++_sp & 255u) == 0u) { if (xb_ld(&(bar)[XB_TMO])) break; if (_sp > XB_SPIN_CAP) { atomicAdd(&(bar)[XB_TMO], 1u); break; } } } } while (0)
struct XcdBarrier { unsigned* bar; unsigned x; volatile LAS unsigned* st; };
DI XcdBarrier xcd_barrier_post(unsigned* bar, volatile LAS unsigned* st) {
    XcdBarrier b; b.bar = bar; b.x = xb_xcc_id(); b.st = st;
    if (threadIdx.x == 0) (void)xb_add(&bar[XB_XCNT(b.x)], 1u);
    return b;
}
DI void xcd_barrier_complete(unsigned* bar, unsigned x, unsigned& nloc, unsigned& nx) {
    const unsigned G = gridDim.x * gridDim.y * gridDim.z;
    unsigned sum, cnt, mine, sp = 0u;
    for (;;) {
        sum = 0u; cnt = 0u; mine = 0u;
#pragma unroll
        for (unsigned j = 0; j < 16; ++j) { const unsigned c = xb_ld(&bar[XB_XCNT(j)]); sum += c; cnt += (c > 0u) ? 1u : 0u; mine = (j == x) ? c : mine; }
        if (sum == G) break;
        __builtin_amdgcn_s_sleep(1);
        if ((++sp & 255u) == 0u) { if (xb_ld(&bar[XB_TMO])) break; if (sp > XB_SPIN_CAP) { atomicAdd(&bar[XB_TMO], 1u); break; } }
    }
    nloc = mine > 0u ? mine : 1u; nx = cnt > 0u ? cnt : 1u;
}
DI void xcd_barrier(const XcdBarrier& b) {
    asm volatile("s_waitcnt vmcnt(0)" ::: "memory");
    __syncthreads();
    if (threadIdx.x == 0) {
        unsigned* bar = b.bar;
        __builtin_amdgcn_s_waitcnt(0);
        unsigned nloc = b.st[0], nx = b.st[1];
        if (nloc == 0u) { xcd_barrier_complete(bar, b.x, nloc, nx); b.st[0] = nloc; b.st[1] = nx; }
        const unsigned old = xb_add(&bar[XB_XSUB(b.x)], 1u);
        const unsigned gen = old / nloc;
        if (old + 1u == (gen + 1u) * nloc) {
            __builtin_amdgcn_fence(__ATOMIC_RELEASE, "agent");
            asm volatile("s_waitcnt vmcnt(0)" ::: "memory");
            const unsigned og = xb_add(&bar[XB_TOP], 1u);
            const unsigned tg = og / nx;
            if (og + 1u == (tg + 1u) * nx) xb_add(&bar[XB_TOPGEN], 1u);
            else XB_SPIN(xb_ld(&bar[XB_TOPGEN]) == tg, bar);
            __builtin_amdgcn_fence(__ATOMIC_ACQUIRE, "agent");
            xb_add(&bar[XB_XGEN(b.x)], 1u);
            asm volatile("s_waitcnt vmcnt(0)" ::: "memory");
        } else {
            XB_SPIN(xb_ld(&bar[XB_XGEN(b.x)]) == gen, bar);
            __builtin_amdgcn_fence(__ATOMIC_ACQUIRE, "agent");
            asm volatile("s_waitcnt vmcnt(0)" ::: "memory");
        }
    }
    __syncthreads();
}

__global__ void __launch_bounds__(NTHREADS, 2) mega(Params p_, int ph_lo, int ph_hi) {
    const Params& p = *(const Params*)__builtin_amdgcn_kernarg_segment_ptr();
    extern __shared__ __attribute__((aligned(16))) char smem[];
    cg::grid_group grid = cg::this_grid();
    __shared__ uint4 xb_words;
    if (threadIdx.x == 0) xb_words = make_uint4(0u, 0u, 0u, 0u);
    __syncthreads();
    XcdBarrier xb = xcd_barrier_post(p.bar, (volatile LAS unsigned*)&xb_words);
    for (int ph = ph_lo; ph < ph_hi; ++ph) {
        if (ph == 0) { prologue_phase(p, smem); if (DBL & 32) prologue_phase(p, smem); }
        else {
            const int l = (ph - 1) >> 2, s = (ph - 1) & 3;
            if (s == 0) { norm_phase(p, l); if (DBL & 1) norm_phase(p, l); }
            else if (s == 1) { inproj_phase(p, l, smem); if (DBL & 2) inproj_phase(p, l, smem); }
            else if (s == 2) { attn_phase(p, l, smem, 0); if (DBL & 4) attn_phase(p, l, smem, 16); }
            else { outproj_phase(p, l, smem); }
        }
        if (ph + 1 < ph_hi) {
            if (ph_hi > NPHASES) grid.sync();
            else { xcd_barrier(xb); if (DBL & 16) xcd_barrier(xb); }
        }
    }
}

extern "C" void kernel_launch(void* const* d_in, const int* in_sizes, int n_in, void* d_out, int out_size, void* d_ws, size_t ws_size,
                              hipStream_t stream) {
    static int grid_blocks = 0;
    if (grid_blocks == 0) {
        int dev = 0, cus = 0, per_cu = 0;
        hipGetDevice(&dev);
        hipDeviceGetAttribute(&cus, hipDeviceAttributeMultiprocessorCount, dev);
        if (hipFuncSetAttribute((const void*)mega, hipFuncAttributeMaxDynamicSharedMemorySize, LDS_BYTES) != hipSuccess) {
            fprintf(stderr, "kernel_launch: hipFuncSetAttribute failed\n"); grid_blocks = -1; return;
        }
        if (hipOccupancyMaxActiveBlocksPerMultiprocessor(&per_cu, (const void*)mega, NTHREADS, LDS_BYTES) != hipSuccess || per_cu < 1) {
            fprintf(stderr, "kernel_launch: occupancy query failed (%d)\n", per_cu); grid_blocks = -1; return;
        }
        if (per_cu > 2) per_cu = 2;
        grid_blocks = cus * per_cu;
        fprintf(stderr, "kernel_launch: %d CUs x %d blocks\n", cus, per_cu);
    }
    if (grid_blocks < 0) return;
    Params p{};
    const float* const* in = (const float* const*)d_in;
    p.x = in[0]; p.c = in[1]; p.ctx = in[2]; p.c_ctx = in[3]; p.norm_g = in[4]; p.w_ada = in[5]; p.b_ada = in[6]; p.w_in = in[7]; p.w_out = in[8];
    p.dqn = in[9]; p.dkn = in[10]; p.lq1 = in[11]; p.lk1 = in[12]; p.lq2 = in[13]; p.lk2 = in[14]; p.subln = in[15];
    p.gqn = in[16]; p.gkn = in[17]; p.nqn = in[18]; p.nkn = in[19]; p.rpb = in[20];
    p.out = (float*)d_out;
    char* w = (char*)d_ws;
    size_t off = 0;
    auto take = [&](size_t bytes) { char* q = w + off; off += (bytes + 255) & ~(size_t)255; return q; };
    p.ctr = (unsigned*)take(256);
    p.bar = (unsigned*)take(XCD_BAR_WORDS * 4);
    p.lam = (float*)take(256);
    p.mod = (float*)take((size_t)DEPTH * 9 * 3072 * 4);
    p.rope64 = (float*)take((size_t)SEQ * 64 * 4);
    p.rope32 = (float*)take((size_t)SEQ * 32 * 4);
    p.xctx = (float*)take((size_t)NB * CTXL * D * 4);
    p.hmix = (bf16_t*)take((size_t)NTOK * D * 2);
    p.qkv = (bf16_t*)take((size_t)NTOK * INW * 2);
    p.vT = (bf16_t*)take((size_t)NB * VW * TPB * 2);
    p.wtin = (bf16_t*)take((size_t)DEPTH * INW * D * 2);
    p.wtout = (bf16_t*)take((size_t)DEPTH * D * D * 2);
    if (off > ws_size) { fprintf(stderr, "kernel_launch: workspace too small (%zu > %zu)\n", off, ws_size); return; }
    if (hipMemsetAsync(p.ctr, 0, (size_t)((char*)p.lam - (char*)p.ctr), stream) != hipSuccess) { fprintf(stderr, "kernel_launch: memset failed\n"); return; }
#if N_LAUNCH_MODE == 1
    int lo = 0, hi = NPHASES;
    void* args[] = {&p, &lo, &hi};
    hipError_t e = hipLaunchCooperativeKernel((const void*)mega, dim3(grid_blocks), dim3(NTHREADS), args, LDS_BYTES, stream);
    if (e != hipSuccess) fprintf(stderr, "cooperative launch failed: %s (grid %d)\n", hipGetErrorString(e), grid_blocks);
#else
    for (int ph = 0; ph < NPHASES; ++ph) hipLaunchKernelGGL(mega, dim3(grid_blocks), dim3(NTHREADS), LDS_BYTES, stream, p, ph, ph + 1);
#endif
}
```

```cpp
#include <hip/hip_runtime.h>
#include <hip/hip_cooperative_groups.h>
#include <cstdio>
#include <cstdint>
namespace cg = cooperative_groups;

#ifndef DBL
#define DBL 0
#endif
#ifndef N_LAUNCH_MODE
#define N_LAUNCH_MODE 1
#endif

#define DI __device__ __forceinline__
typedef unsigned short bf16_t;
typedef short bf16x8 __attribute__((ext_vector_type(8)));
typedef short s16x4 __attribute__((ext_vector_type(4)));
typedef float f32x16 __attribute__((ext_vector_type(16)));
typedef __bf16 bf2_t __attribute__((ext_vector_type(2)));
typedef float f2_t __attribute__((ext_vector_type(2)));
#define MFMA(a, b, c) __builtin_amdgcn_mfma_f32_32x32x16_bf16((a), (b), (c), 0, 0, 0)

constexpr int D = 1024, NB = 8, SEQ = 2048, CTXL = 256, TPB = 2304, NTOK = NB * TPB, INW = 3584, DEPTH = 4, VW = 768;
constexpr int NTHREADS = 256;
constexpr int LDS_BYTES = 73728;
constexpr int NPHASES = 1 + 4 * DEPTH;
constexpr float EPS = 1e-6f;
constexpr float LOG2E = 1.4426950408889634f;

struct Params {
    const float *x, *c, *ctx, *c_ctx, *norm_g, *w_ada, *b_ada, *w_in, *w_out;
    const float *dqn, *dkn, *lq1, *lk1, *lq2, *lk2, *subln, *gqn, *gkn, *nqn, *nkn, *rpb;
    float* out;
    float* xctx;
    bf16_t* hmix;
    bf16_t* qkv;
    bf16_t* vT;
    bf16_t* wtin;
    bf16_t* wtout;
    float* mod;
    float* rope64;
    float* rope32;
    float* lam;
    unsigned* ctr;
    unsigned* bar;
};

DI unsigned pk2(float a, float b) { f2_t v = {a, b}; bf2_t r = __builtin_convertvector(v, bf2_t); return __builtin_bit_cast(unsigned, r); }
DI float bf2f(bf16_t v) { return __uint_as_float(((unsigned)v) << 16); }
DI int otid() { int t = threadIdx.x; asm volatile("" : "+v"(t)); return t; }
typedef unsigned u32x4_t __attribute__((ext_vector_type(4)));
DI void ldg_async(u32x4_t& r, const void* p) { asm volatile("global_load_dwordx4 %0, %1, off" : "=v"(r) : "v"(p)); }
#define WAIT_LOADS8(a, b, c, d, e, f, g, h) asm volatile("s_waitcnt vmcnt(0)" : "+v"(a), "+v"(b), "+v"(c), "+v"(d), "+v"(e), "+v"(f), "+v"(g), "+v"(h) :: "memory")
#define WAIT_LOADS4(a, b, c, d) asm volatile("s_waitcnt vmcnt(0)" : "+v"(a), "+v"(b), "+v"(c), "+v"(d) :: "memory")
DI int crow(int reg, int h) { return (reg & 3) + 8 * (reg >> 2) + 4 * h; }
DI float silu_f(float v) { return v * __builtin_amdgcn_rcpf(1.f + __builtin_amdgcn_exp2f(-1.4426950408889634f * v)); }
DI float lam_init_f(int l) { return 0.8f - 0.6f * expf(-0.3f * (float)l); }

DI const float* src_row(const Params& p, int l, int b, int t) {
    if (l == 0) return t < SEQ ? p.x + ((size_t)b * SEQ + t) * D : p.ctx + ((size_t)b * CTXL + (t - SEQ)) * D;
    return t < SEQ ? p.out + ((size_t)b * SEQ + t) * D : p.xctx + ((size_t)b * CTXL + (t - SEQ)) * D;
}
DI float* dst_row(const Params& p, int b, int t) {
    return t < SEQ ? p.out + ((size_t)b * SEQ + t) * D : p.xctx + ((size_t)b * CTXL + (t - SEQ)) * D;
}

DI void transpose_item(const float* __restrict__ src, bf16_t* __restrict__ dst, int K, int N, int kt, int nt, char* smem) {
    float* tile = (float*)smem;
    const int tid = otid();
#pragma unroll
    for (int i = 0; i < 4; ++i) {
        const int c = tid + 256 * i, r = c >> 4, cc = c & 15;
        const float4 v = *(const float4*)(src + (size_t)(kt * 64 + r) * N + nt * 64 + cc * 4);
        tile[r * 65 + cc * 4 + 0] = v.x; tile[r * 65 + cc * 4 + 1] = v.y; tile[r * 65 + cc * 4 + 2] = v.z; tile[r * 65 + cc * 4 + 3] = v.w;
    }
    __syncthreads();
#pragma unroll
    for (int i = 0; i < 2; ++i) {
        const int c = tid + 256 * i, n = c >> 3, kc = c & 7;
        float f[8];
#pragma unroll
        for (int j = 0; j < 8; ++j) f[j] = tile[(kc * 8 + j) * 65 + n];
        uint4 o; o.x = pk2(f[0], f[1]); o.y = pk2(f[2], f[3]); o.z = pk2(f[4], f[5]); o.w = pk2(f[6], f[7]);
        *(uint4*)(dst + ((size_t)(2 * kt + (kc >> 2)) * N + nt * 64 + n) * 32 + (kc & 3) * 8) = o;
    }
    __syncthreads();
}

DI void adaln_item(const Params& p, int item, char* smem) {
    float* sc = (float*)smem;
    float* red = sc + 9 * 1024;
    const int tid = otid();
    const int l = item / 96, col0 = (item % 96) * 32;
    for (int i = tid; i < 9 * 1024; i += 256) {
        const int r = i >> 10, k = i & 1023;
        const float v = r < 8 ? p.c[r * 1024 + k] : p.c_ctx[k];
        sc[i] = v / (1.f + expf(-v));
    }
    __syncthreads();
    const int col = tid & 31, kg = tid >> 5;
    float acc[9];
#pragma unroll
    for (int r = 0; r < 9; ++r) acc[r] = 0.f;
    const float* w = p.w_ada + ((size_t)l * 1024 + kg * 128) * 3072 + col0 + col;
#pragma unroll 8
    for (int k = 0; k < 128; ++k) {
        const float wv = w[(size_t)k * 3072];
#pragma unroll
        for (int r = 0; r < 9; ++r) acc[r] += sc[r * 1024 + kg * 128 + k] * wv;
    }
#pragma unroll
    for (int r = 0; r < 9; ++r) red[(kg * 9 + r) * 32 + col] = acc[r];
    __syncthreads();
    for (int i = tid; i < 9 * 32; i += 256) {
        const int r = i >> 5, cc = i & 31;
        float s = 0.f;
#pragma unroll
        for (int g = 0; g < 8; ++g) s += red[(g * 9 + r) * 32 + cc];
        p.mod[((size_t)l * 9 + r) * 3072 + col0 + cc] = s + p.b_ada[l * 3072 + col0 + cc];
    }
    __syncthreads();
}

DI void prologue_phase(const Params& p, char* smem) {
    const int nb = gridDim.x, bid = blockIdx.x, tid = otid();
    constexpr int N_ADA = DEPTH * 96, N_TIN = DEPTH * 16 * 56, N_TOUT = DEPTH * 16 * 16;
    for (int it = bid; it < N_ADA + N_TIN + N_TOUT; it += nb) {
        if (it < N_ADA) adaln_item(p, it, smem);
        else if (it < N_ADA + N_TIN) {
            const int j = it - N_ADA, l = j / (16 * 56), r = j % (16 * 56), kt = r / 56, nt = r % 56;
            transpose_item(p.w_in + (size_t)l * D * INW, p.wtin + (size_t)l * INW * D, D, INW, kt, nt, smem);
        } else {
            const int j = it - N_ADA - N_TIN, l = j / 256, r = j % 256, kt = r / 16, nt = r % 16;
            transpose_item(p.w_out + (size_t)l * D * D, p.wtout + (size_t)l * D * D, D, D, kt, nt, smem);
        }
    }
    const int gtid = bid * NTHREADS + tid, gn = nb * NTHREADS;
    const float l2t = 13.287712379549449f;
    for (int i = gtid; i < SEQ * 32; i += gn) {
        const int t = i >> 5, k = i & 31;
        const float pos = (k < 16) ? (float)(t >> 6) : (float)(t & 63);
        const float inv = exp2f(-(float)(k & 15) * (1.f / 16.f) * l2t);
        const float ang = pos * inv;
        p.rope64[2 * (k * SEQ + t)] = cosf(ang); p.rope64[2 * (k * SEQ + t) + 1] = sinf(ang);
    }
    for (int i = gtid; i < SEQ * 16; i += gn) {
        const int t = i >> 4, k = i & 15;
        const float pos = (k < 8) ? (float)(t >> 6) : (float)(t & 63);
        const float inv = exp2f(-(float)(k & 7) * (1.f / 8.f) * l2t);
        const float ang = pos * inv;
        p.rope32[2 * (k * SEQ + t)] = cosf(ang); p.rope32[2 * (k * SEQ + t) + 1] = sinf(ang);
    }
    if (bid == 0 && tid < DEPTH) {
        const int l = tid;
        float s1 = 0.f, s2 = 0.f;
        for (int i = 0; i < 32; ++i) { s1 += p.lq1[l * 32 + i] * p.lk1[l * 32 + i]; s2 += p.lq2[l * 32 + i] * p.lk2[l * 32 + i]; }
        p.lam[l] = expf(s1) - expf(s2) + lam_init_f(l);
        p.lam[4 + l] = 1.f - lam_init_f(l);
        float a = 0.f, bq = 0.f, c = 0.f, d2 = 0.f, e2 = 0.f, f2 = 0.f, g = 0.f;
        for (int i = 0; i < 32; ++i) { a = fmaxf(a, fabsf(p.dqn[l * 32 + i])); bq = fmaxf(bq, fabsf(p.dkn[l * 32 + i])); }
        for (int i = 0; i < 64; ++i) { c = fmaxf(c, fabsf(p.gqn[l * 64 + i])); d2 = fmaxf(d2, fabsf(p.gkn[l * 64 + i])); e2 = fmaxf(e2, fabsf(p.nqn[l * 64 + i])); f2 = fmaxf(f2, fabsf(p.nkn[l * 64 + i])); }
        for (int i = 0; i < 6 * 465; ++i) g = fmaxf(g, fabsf(p.rpb[(size_t)l * 6 * 465 + i]));
        p.lam[8 + l * 4 + 0] = 5.656854249f * a * bq * LOG2E * 1.001f;
        p.lam[8 + l * 4 + 1] = 8.f * c * d2 * LOG2E * 1.001f;
        p.lam[8 + l * 4 + 2] = (8.f * e2 * f2 + g) * LOG2E * 1.001f;
        p.lam[8 + l * 4 + 3] = 8.f * e2 * f2 * LOG2E * 1.001f;
    }
}

DI void norm_phase(const Params& p, int l) {
    const int tid_ = otid(), lane = tid_ & 63, wave = tid_ >> 6;
    const int gw = blockIdx.x * 4 + wave, nw = gridDim.x * 4;
    const float* g = p.norm_g + l * D;
    float4 gg[4];
#pragma unroll
    for (int j = 0; j < 4; ++j) gg[j] = *(const float4*)(g + 256 * j + 4 * lane);
    for (int row0 = gw; row0 < NTOK; row0 += 3 * nw) {
        float4 v[3][4];
        const float* md[3];
#pragma unroll
        for (int u = 0; u < 3; ++u) {
            const int row = row0 + u * nw;
            const int rc = row < NTOK ? row : gw;
            const int b = rc / TPB, t = rc % TPB;
            const float* src = src_row(p, l, b, t);
            md[u] = p.mod + ((size_t)l * 9 + (t < SEQ ? b : 8)) * 3072;
#pragma unroll
            for (int j = 0; j < 4; ++j) v[u][j] = *(const float4*)(src + 256 * j + 4 * lane);
        }
#pragma unroll
        for (int u = 0; u < 3; ++u) {
            const int row = row0 + u * nw;
            float4 sh[4], sc[4];
#pragma unroll
            for (int j = 0; j < 4; ++j) { sh[j] = *(const float4*)(md[u] + 256 * j + 4 * lane); sc[j] = *(const float4*)(md[u] + 1024 + 256 * j + 4 * lane); }
            float ss = 0.f;
#pragma unroll
            for (int j = 0; j < 4; ++j) ss += v[u][j].x * v[u][j].x + v[u][j].y * v[u][j].y + v[u][j].z * v[u][j].z + v[u][j].w * v[u][j].w;
#pragma unroll
            for (int o = 1; o < 64; o <<= 1) ss += __shfl_xor(ss, o);
            const float rstd = rsqrtf(ss * (1.f / D) + EPS);
            if (row < NTOK) {
                bf16_t* dst = p.hmix + (size_t)row * 32;
#pragma unroll
                for (int j = 0; j < 4; ++j) {
                    const int k = 256 * j + 4 * lane;
                    const float o0 = (v[u][j].x * rstd * gg[j].x) * (1.f + sc[j].x) + sh[j].x;
                    const float o1 = (v[u][j].y * rstd * gg[j].y) * (1.f + sc[j].y) + sh[j].y;
                    const float o2 = (v[u][j].z * rstd * gg[j].z) * (1.f + sc[j].z) + sh[j].z;
                    const float o3 = (v[u][j].w * rstd * gg[j].w) * (1.f + sc[j].w) + sh[j].w;
                    uint2 o; o.x = pk2(o0, o1); o.y = pk2(o2, o3);
                    *(uint2*)(dst + (size_t)(k >> 5) * NTOK * 32 + (k & 31)) = o;
                }
            }
        }
    }
}

typedef __attribute__((address_space(3))) unsigned lds_u32;
DI void dma16(const void* g, char* l) { __builtin_amdgcn_global_load_lds((const unsigned*)g, (lds_u32*)l, 16, 0, 0); }
template <bool VMODE, int TJ>
DI void gemm_mainloop(const bf16_t* __restrict__ W, const bf16_t* __restrict__ X, int NW, char* smem, f32x16 (&acc)[2][TJ]) {
    constexpr int XROWS = 64 * TJ, STAGE = (128 + XROWS) * 64, NPW = 2 + TJ;
    const int tid = otid(), lane = tid & 63, wave = tid >> 6, r = lane & 31, h = lane >> 5, wf = wave & 1, wt = wave >> 1;
    const int goff = (16 * wave + (lane >> 2)) * 32 + (((lane & 3) ^ (lane >> 4)) << 3);
    const bf16_t* wp = W + goff;
    const bf16_t* xp = X + goff;
    const size_t wks = (size_t)NW * 32, xks = (size_t)NTOK * 32;
    char* ld = smem + tid * 16;
#define G_ISSUE(ks_, buf_) do { \
    const bf16_t* wq_ = wp + (ks_) * wks; const bf16_t* xq_ = xp + (ks_) * xks; char* lb_ = ld + (buf_) * STAGE; \
    dma16(wq_, lb_); dma16(wq_ + 2048, lb_ + 4096); \
    _Pragma("unroll") for (int i_ = 0; i_ < TJ; ++i_) dma16(xq_ + i_ * 2048, lb_ + 8192 + i_ * 4096); } while (0)
    const int xr = (r >> 2) & 3;
    const int fo0 = r * 64 + (((0 + h) ^ xr) << 4), fo1 = r * 64 + (((2 + h) ^ xr) << 4);
    __syncthreads();
#define G_COMPUTE(slot_) do { \
        const char* sw = smem + (slot_) * STAGE + wf * 64 * 64; \
        const char* sx = smem + (slot_) * STAGE + 8192 + wt * (32 * TJ) * 64; \
        _Pragma("unroll") for (int s = 0; s < 2; ++s) { \
            const int fo = (s == 0) ? fo0 : fo1; \
            bf16x8 fw[2], fx[TJ]; \
            _Pragma("unroll") for (int i = 0; i < 2; ++i) fw[i] = *(const bf16x8*)(sw + i * 32 * 64 + fo); \
            _Pragma("unroll") for (int j = 0; j < TJ; ++j) fx[j] = *(const bf16x8*)(sx + j * 32 * 64 + fo); \
            _Pragma("unroll") for (int i = 0; i < 2; ++i) \
                _Pragma("unroll") for (int j = 0; j < TJ; ++j) \
                    acc[i][j] = VMODE ? MFMA(fx[j], fw[i], acc[i][j]) : MFMA(fw[i], fx[j], acc[i][j]); \
        } } while (0)
    if (TJ <= 2) {
        constexpr int NSL = (TJ == 1) ? 6 : 4;
        G_ISSUE(0, 0);
        G_ISSUE(1, 1);
        if (TJ == 1) { G_ISSUE(2, 2); G_ISSUE(3, 3); }
        int sl = 0;
        for (int kp = 0; kp < 16; ++kp) {
            if (TJ == 1 && kp + 1 < 16) asm volatile("s_waitcnt vmcnt(6)" ::: "memory");
            else asm volatile("s_waitcnt vmcnt(0)" ::: "memory");
            __builtin_amdgcn_s_barrier();
            const int sn2 = (TJ == 1) ? ((sl + 4 >= NSL) ? sl + 4 - NSL : sl + 4) : 2 - sl;
            {
                const char* sw = smem + sl * STAGE + wf * 64 * 64;
                const char* sx = smem + sl * STAGE + 8192 + wt * (32 * TJ) * 64;
                bf16x8 fw[2], fx[TJ];
#pragma unroll
                for (int i = 0; i < 2; ++i) fw[i] = *(const bf16x8*)(sw + i * 32 * 64 + fo0);
#pragma unroll
                for (int j = 0; j < TJ; ++j) fx[j] = *(const bf16x8*)(sx + j * 32 * 64 + fo0);
                __builtin_amdgcn_sched_barrier(0);
                if (TJ == 1) { if (kp + 2 < 16) { G_ISSUE(2 * kp + 4, sn2); G_ISSUE(2 * kp + 5, sn2 + 1); } }
                else if (kp + 1 < 16) { G_ISSUE(2 * kp + 2, sn2); G_ISSUE(2 * kp + 3, sn2 + 1); }
                __builtin_amdgcn_sched_barrier(0);
#pragma unroll
                for (int i = 0; i < 2; ++i)
#pragma unroll
                    for (int j = 0; j < TJ; ++j) acc[i][j] = VMODE ? MFMA(fx[j], fw[i], acc[i][j]) : MFMA(fw[i], fx[j], acc[i][j]);
#pragma unroll
                for (int i = 0; i < 2; ++i) fw[i] = *(const bf16x8*)(sw + i * 32 * 64 + fo1);
#pragma unroll
                for (int j = 0; j < TJ; ++j) fx[j] = *(const bf16x8*)(sx + j * 32 * 64 + fo1);
#pragma unroll
                for (int i = 0; i < 2; ++i)
#pragma unroll
                    for (int j = 0; j < TJ; ++j) acc[i][j] = VMODE ? MFMA(fx[j], fw[i], acc[i][j]) : MFMA(fw[i], fx[j], acc[i][j]);
            }
            G_COMPUTE(sl + 1);
            sl = (sl + 2 >= NSL) ? 0 : sl + 2;
        }
    } else {
        G_ISSUE(0, 0);
        G_ISSUE(1, 1);
        int bc = 0, bn = 2;
        for (int ks = 0; ks < 32; ++ks) {
            if (ks < 31) asm volatile("s_waitcnt vmcnt(6)" ::: "memory");
            else asm volatile("s_waitcnt vmcnt(0)" ::: "memory");
            __builtin_amdgcn_s_barrier();
            const char* sw = smem + bc * STAGE + wf * 64 * 64;
            const char* sx = smem + bc * STAGE + 8192 + wt * (32 * TJ) * 64;
            bf16x8 fw[2], fx[TJ], gw[2], gx[TJ];
#pragma unroll
            for (int i = 0; i < 2; ++i) fw[i] = *(const bf16x8*)(sw + i * 32 * 64 + fo0);
#pragma unroll
            for (int j = 0; j < TJ; ++j) fx[j] = *(const bf16x8*)(sx + j * 32 * 64 + fo0);
            __builtin_amdgcn_sched_barrier(0);
            if (ks + 2 < 32) G_ISSUE(ks + 2, bn);
            __builtin_amdgcn_sched_barrier(0);
#pragma unroll
            for (int i = 0; i < 2; ++i) gw[i] = *(const bf16x8*)(sw + i * 32 * 64 + fo1);
#pragma unroll
            for (int j = 0; j < TJ; ++j) gx[j] = *(const bf16x8*)(sx + j * 32 * 64 + fo1);
#pragma unroll
            for (int i = 0; i < 2; ++i)
#pragma unroll
                for (int j = 0; j < TJ; ++j) acc[i][j] = VMODE ? MFMA(fx[j], fw[i], acc[i][j]) : MFMA(fw[i], fx[j], acc[i][j]);
#pragma unroll
            for (int i = 0; i < 2; ++i)
#pragma unroll
                for (int j = 0; j < TJ; ++j) acc[i][j] = VMODE ? MFMA(gx[j], gw[i], acc[i][j]) : MFMA(gw[i], gx[j], acc[i][j]);
            bc = (bc == 2) ? 0 : bc + 1; bn = (bn == 2) ? 0 : bn + 1;
        }
    }
#undef G_COMPUTE
    __syncthreads();
#undef G_ISSUE
}

template <int TJ>
DI void zero_acc(f32x16 (&acc)[2][TJ]) {
#pragma unroll
    for (int i = 0; i < 2; ++i)
#pragma unroll
        for (int j = 0; j < TJ; ++j)
#pragma unroll
            for (int e = 0; e < 16; ++e) acc[i][j][e] = 0.f;
}

DI void stage_quad_bf16(char* sb, int row, int c16, int half, uint2 v) { *(uint2*)(sb + row * 128 + ((c16 ^ (row & 7)) << 4) + (half << 3)) = v; }
template <int NIT>
DI void stage_flush_bf16(const char* sb, bf16_t* gdst, int lane) {
#pragma unroll
    for (int it = 0; it < NIT; ++it) {
        const int c = lane + 64 * it, row = c >> 3, lc = (c & 7) ^ (row & 7);
        const u32x4_t v = *(const u32x4_t*)(sb + c * 16);
        *(u32x4_t*)(gdst + row * 64 + lc * 8) = v;
    }
}
DI void store_tile_bf16(bf16_t* orow, const f32x16& a, int h) {
#pragma unroll
    for (int q = 0; q < 4; ++q) {
        uint2 o; o.x = pk2(a[4 * q], a[4 * q + 1]); o.y = pk2(a[4 * q + 2], a[4 * q + 3]);
        *(uint2*)(orow + 8 * q + 4 * h) = o;
    }
}

DI void epi_inproj(const Params& p, int l, int mtile, int n0, f32x16 (&acc)[2][4], char* smem) {
    const int tid = otid(), lane = tid & 63, wave = tid >> 6, r = lane & 31, h = lane >> 5, wf = wave & 1, wt = wave >> 1;
    char* sb = smem + wave * 16384;
    const int b = mtile / 9, tt = mtile % 9, t0 = tt * 256;
    const bool latent = tt < 8;
    const int nw = n0 + 64 * wf;
    int type; const float* nwt = nullptr; bool rope = false;
    if (n0 < 256) { type = 2; nwt = p.dqn + l * 32; rope = true; }
    else if (n0 < 512) { type = 2; nwt = p.dkn + l * 32; rope = true; }
    else if (n0 < 1024) { type = 1; }
    else if (n0 < 1408) { type = 3; nwt = p.gqn + l * 64; rope = true; }
    else if (n0 < 1536) { type = 3; nwt = p.gkn + l * 64; rope = true; }
    else if (n0 < 2048) { type = 1; }
    else if (n0 < 2432) { type = 3; nwt = p.nqn + l * 64; }
    else if (n0 < 2816) { type = 3; nwt = p.nkn + l * 64; }
    else { type = 1; }
    rope = rope && latent;
    const float qs = (n0 < 256) ? 0.17677669529663687f * LOG2E : ((n0 >= 1024 && n0 < 1408) || (n0 >= 2048 && n0 < 2432)) ? 0.125f * LOG2E : 1.f;
#pragma unroll
    for (int j = 0; j < 4; ++j) {
        const int t = t0 + 128 * wt + 32 * j + r;
        if (type == 1) {
#pragma unroll
            for (int i = 0; i < 2; ++i) {
#pragma unroll
                for (int e = 0; e < 16; ++e) acc[i][j][e] = silu_f(acc[i][j][e]);
            }
        } else if (type == 3) {
            float ss = 0.f;
#pragma unroll
            for (int i = 0; i < 2; ++i)
#pragma unroll
                for (int e = 0; e < 16; ++e) ss += acc[i][j][e] * acc[i][j][e];
            ss += __shfl_xor(ss, 32);
            const float rstd = rsqrtf(ss * (1.f / 64.f) + EPS) * qs;
#pragma unroll
            for (int i = 0; i < 2; ++i)
#pragma unroll
                for (int q = 0; q < 4; ++q) {
                    const float4 w4 = *(const float4*)(nwt + 32 * i + 8 * q + 4 * h);
                    acc[i][j][4 * q + 0] *= rstd * w4.x; acc[i][j][4 * q + 1] *= rstd * w4.y;
                    acc[i][j][4 * q + 2] *= rstd * w4.z; acc[i][j][4 * q + 3] *= rstd * w4.w;
                }
            if (rope) {
                const float* tab = p.rope64 + (size_t)t * 2;
#pragma unroll
                for (int q = 0; q < 4; ++q) {
#pragma unroll
                    for (int e = 0; e < 4; ++e) {
                        const float2 cs = *(const float2*)(tab + (size_t)(8 * q + 4 * h + e) * (SEQ * 2));
                        const float x1 = acc[0][j][4 * q + e], x2 = acc[1][j][4 * q + e];
                        acc[0][j][4 * q + e] = x1 * cs.x - x2 * cs.y;
                        acc[1][j][4 * q + e] = x2 * cs.x + x1 * cs.y;
                    }
                }
            }
        } else {
#pragma unroll
            for (int i = 0; i < 2; ++i) {
                float ss = 0.f;
#pragma unroll
                for (int e = 0; e < 16; ++e) ss += acc[i][j][e] * acc[i][j][e];
                ss += __shfl_xor(ss, 32);
                const float rstd = rsqrtf(ss * (1.f / 32.f) + EPS) * qs;
#pragma unroll
                for (int q = 0; q < 4; ++q) {
                    const float4 w4 = *(const float4*)(nwt + 8 * q + 4 * h);
                    acc[i][j][4 * q + 0] *= rstd * w4.x; acc[i][j][4 * q + 1] *= rstd * w4.y;
                    acc[i][j][4 * q + 2] *= rstd * w4.z; acc[i][j][4 * q + 3] *= rstd * w4.w;
                }
                if (rope) {
                    const float* tab = p.rope32 + (size_t)t * 2;
#pragma unroll
                    for (int q = 0; q < 2; ++q) {
#pragma unroll
                        for (int e = 0; e < 4; ++e) {
                            const float2 cs = *(const float2*)(tab + (size_t)(8 * q + 4 * h + e) * (SEQ * 2));
                            const float x1 = acc[i][j][4 * q + e], x2 = acc[i][j][4 * q + 8 + e];
                            acc[i][j][4 * q + e] = x1 * cs.x - x2 * cs.y;
                            acc[i][j][4 * q + 8 + e] = x2 * cs.x + x1 * cs.y;
                        }
                    }
                }
            }
        }
#pragma unroll
        for (int i = 0; i < 2; ++i)
#pragma unroll
            for (int q = 0; q < 4; ++q) {
                uint2 o; o.x = pk2(acc[i][j][4 * q], acc[i][j][4 * q + 1]); o.y = pk2(acc[i][j][4 * q + 2], acc[i][j][4 * q + 3]);
                stage_quad_bf16(sb, 32 * j + r, 4 * i + q, h, o);
            }
    }
    stage_flush_bf16<16>(sb, p.qkv + ((size_t)(nw >> 6) * NTOK + (size_t)b * TPB + t0 + 128 * wt) * 64, lane);
}

DI void epi_v(const Params& p, int mtile, int vf0, f32x16 (&acc)[2][4], char* smem) {
    const int tid = otid(), lane = tid & 63, wave = tid >> 6, r = lane & 31, h = lane >> 5, wf = wave & 1, wt = wave >> 1;
    const int b = mtile / 9, t0 = (mtile % 9) * 256;
    char* sb = smem + wave * 16384;
#pragma unroll
    for (int i = 0; i < 2; ++i)
#pragma unroll
        for (int j = 0; j < 4; ++j)
#pragma unroll
            for (int q = 0; q < 4; ++q) {
                uint2 o; o.x = pk2(acc[i][j][4 * q], acc[i][j][4 * q + 1]); o.y = pk2(acc[i][j][4 * q + 2], acc[i][j][4 * q + 3]);
                stage_quad_bf16(sb + (j >> 1) * 8192, 32 * i + r, 4 * (j & 1) + 2 * (q >> 1) + h, q & 1, o);
            }
    bf16_t* g0 = p.vT + (((size_t)b * 12 + (vf0 >> 6) + wf) * 36 + (t0 >> 6) + 2 * wt) * 4096;
    stage_flush_bf16<8>(sb, g0, lane);
    stage_flush_bf16<8>(sb + 8192, g0 + 4096, lane);
}

DI void inproj_phase(const Params& p, int l, char* smem) {
    constexpr int NT = 28, MT = NTOK / 256;
    const bool xmap = gridDim.x == 512;
    const int xcd = blockIdx.x & 7, xj = blockIdx.x >> 3;
    for (int it = 0;; ++it) {
        int mtile, nt;
        if (xmap) {
            if (it >= 4 || xj >= 63) break;
            mtile = 9 * xcd + (xj % 9); nt = 7 * it + (xj / 9);
        } else {
            const int tile = blockIdx.x + it * gridDim.x;
            if (tile >= MT * NT) break;
            mtile = tile / NT; nt = tile % NT;
        }
        const int n0 = nt * 128;
        const bf16_t* W = p.wtin + (size_t)l * INW * D + (size_t)n0 * 32;
        const bf16_t* X = p.hmix + (size_t)mtile * 256 * 32;
        f32x16 acc[2][4];
        zero_acc<4>(acc);
        int vf0 = -1;
        if (n0 >= 512 && n0 < 768) vf0 = n0 - 512;
        else if (n0 >= 1536 && n0 < 1664) vf0 = 256 + (n0 - 1536);
        else if (n0 >= 2816 && n0 < 3200) vf0 = 384 + (n0 - 2816);
        if (vf0 >= 0) { gemm_mainloop<true, 4>(W, X, INW, smem, acc); epi_v(p, mtile, vf0, acc, smem); }
        else { gemm_mainloop<false, 4>(W, X, INW, smem, acc); epi_inproj(p, l, mtile, n0, acc, smem); }
    }
}

template <int TJ>
DI void outproj_tile(const Params& p, int l, char* smem, int b, int trow0, int n0) {
    const int tid = otid(), lane = tid & 63, wave = tid >> 6, r = lane & 31, h = lane >> 5, wf = wave & 1, wt = wave >> 1;
    const bf16_t* W = p.wtout + (size_t)l * D * D + (size_t)n0 * 32;
    const bf16_t* X = p.hmix + ((size_t)b * TPB + trow0) * 32;
    f32x16 acc[2][TJ];
    zero_acc<TJ>(acc);
    gemm_mainloop<false, TJ>(W, X, D, smem, acc);
    if (DBL & 8) { zero_acc<TJ>(acc); gemm_mainloop<false, TJ>(W, X, D, smem, acc); }
    const float* gt = p.mod + ((size_t)l * 9 + (trow0 < SEQ ? b : 8)) * 3072 + 2048 + n0 + 64 * wf;
    const float* xs = src_row(p, l, b, trow0 + 32 * TJ * wt) + n0 + 64 * wf;
    float* xd = dst_row(p, b, trow0 + 32 * TJ * wt) + n0 + 64 * wf;
    char* sb = smem + wave * 8192;
    float4 xo[2][4 * TJ];
#pragma unroll
    for (int i = 0; i < 2; ++i)
#pragma unroll
        for (int it = 0; it < 4 * TJ; ++it) {
            const int c = lane + 64 * it, row = c >> 3, f = 32 * i + 4 * ((c & 7) ^ (row & 7));
            xo[i][it] = *(const float4*)(xs + (size_t)row * D + f);
        }
#pragma unroll
    for (int i = 0; i < 2; ++i) {
#pragma unroll
        for (int j = 0; j < TJ; ++j)
#pragma unroll
            for (int q = 0; q < 4; ++q) {
                const int row = 32 * j + r, c16 = 2 * q + h;
                float4 y; y.x = acc[i][j][4 * q]; y.y = acc[i][j][4 * q + 1]; y.z = acc[i][j][4 * q + 2]; y.w = acc[i][j][4 * q + 3];
                *(float4*)(sb + row * 128 + ((c16 ^ (row & 7)) << 4)) = y;
            }
#pragma unroll
        for (int it = 0; it < 4 * TJ; ++it) {
            const int c = lane + 64 * it, row = c >> 3, f = 32 * i + 4 * ((c & 7) ^ (row & 7));
            const float4 y = *(const float4*)(sb + c * 16);
            const float4 g4 = *(const float4*)(gt + f);
            float4 o;
            o.x = xo[i][it].x + g4.x * y.x; o.y = xo[i][it].y + g4.y * y.y; o.z = xo[i][it].z + g4.z * y.z; o.w = xo[i][it].w + g4.w * y.w;
            *(float4*)(xd + (size_t)row * D + f) = o;
        }
    }
}
DI void outproj_phase(const Params& p, int l, char* smem) {
    constexpr int NT = 8, MT = NTOK / 128;
    const bool xmap = gridDim.x == 512;
    const int xcd = blockIdx.x & 7, xj = blockIdx.x >> 3;
    const bool ctxu = l < DEPTH - 1;
    if (xmap) {
#pragma unroll 1
        for (int it = 0; it < 2; ++it) { const int idx = it * 64 + xj; outproj_tile<2>(p, l, smem, xcd, (idx >> 3) * 128, (idx & 7) * 128); }
        if (ctxu && xj < 32) { const int tile = xj >> 1; outproj_tile<1>(p, l, smem, xcd, SEQ + (tile >> 3) * 128 + (xj & 1) * 64, (tile & 7) * 128); }
    } else {
        for (int tile = blockIdx.x; tile < MT * NT; tile += gridDim.x) {
            const int mtile = tile / NT, nt = tile % NT;
            if (!ctxu && (mtile % 18) >= 16) continue;
            outproj_tile<2>(p, l, smem, mtile / 18, (mtile % 18) * 128, nt * 128);
        }
    }
}

constexpr int ATT_SLOT = 16384, ATT_V = 8192, ATT_BIAS = 49152;
#define KV_ISSUE(tile_, slot_) do { \
    const bf16_t* kp_ = kbase + (size_t)(tile_) * 4096 + kvoff; const bf16_t* vp_ = vbase + (size_t)(tile_) * 4096 + kvoff; \
    char* lp_ = smem + (slot_) * ATT_SLOT + tid * 16; \
    dma16(kp_, lp_); dma16(kp_ + 2048, lp_ + 4096); dma16(vp_, lp_ + ATT_V); dma16(vp_ + 2048, lp_ + ATT_V + 4096); } while (0)

DI bf16x8 pack8(const f32x16& x, int s) {
    union { unsigned u[4]; bf16x8 v; } o;
    o.u[0] = pk2(x[8 * s + 0], x[8 * s + 1]); o.u[1] = pk2(x[8 * s + 2], x[8 * s + 3]);
    o.u[2] = pk2(x[8 * s + 4], x[8 * s + 5]); o.u[3] = pk2(x[8 * s + 6], x[8 * s + 7]);
    return o.v;
}
DI bf16x8 ldv_frag(const char* sv, int drow, int c, int xr) {
    return *(const bf16x8*)(sv + drow * 128 + ((c ^ xr) << 4));
}

DI void softmax_tile(f32x16 (&S)[2], float& lsum) {
    f2_t ps = {0.f, 0.f};
#pragma unroll
    for (int t = 0; t < 2; ++t)
#pragma unroll
        for (int e = 0; e < 16; e += 2) {
            f2_t pv; pv.x = __builtin_amdgcn_exp2f(S[t][e]); pv.y = __builtin_amdgcn_exp2f(S[t][e + 1]);
            S[t][e] = pv.x; S[t][e + 1] = pv.y;
            ps += pv;
        }
    lsum += ps.x + ps.y;
}
DI void pv_tile(const f32x16 (&S)[2], f32x16 (&O)[2], const bf16x8 (&vf)[8]) {
#pragma unroll
    for (int s = 0; s < 4; ++s) {
        const bf16x8 pf = pack8(S[s >> 1], s & 1);
#pragma unroll
        for (int dt = 0; dt < 2; ++dt) O[dt] = MFMA(vf[2 * s + dt], pf, O[dt]);
    }
}

template <int KIND>
DI void attn_unit(const Params& p, int l, int b, int head, int qt, int qcol, int kcol, int vfeat, int gcol, int mixcol,
                  int t1, int n1, int t2, int n2, char* smem) {
    const int tid = otid(), lane = tid & 63, wave = tid >> 6, r = lane & 31, h = lane >> 5;
    const int tq = qt * 128 + 32 * wave + r;
    const size_t qrow = (size_t)b * TPB + tq;
    const bf16_t* kbase = p.qkv + ((size_t)(kcol >> 6) * NTOK + (size_t)b * TPB) * 64;
    const bf16_t* vbase = p.vT + ((size_t)b * 12 + (vfeat >> 6)) * 36 * 4096;
    const int nt = n1 + n2;

    bf16x8 qf[4];
    {
        const bf16_t* qp = p.qkv + ((size_t)(qcol >> 6) * NTOK + qrow) * 64 + 8 * h;
#pragma unroll
        for (int s = 0; s < 4; ++s) qf[s] = *(const bf16x8*)(qp + 16 * s);
    }
    int nrow = 0, r0w = 0, qc = 0, c0 = 0;
    if (KIND == 2) {
        nrow = 2 * qt + (wave >> 1); r0w = min(max(nrow - 4, 0), 24);
        qc = 32 * (wave & 1) + r; c0 = min(max(qc - 8, 0), 48);
        float* bias = (float*)(smem + ATT_BIAS);
        for (int i = tid; i < 15 * 32; i += NTHREADS) { const int rr = i >> 5, cc = i & 31; bias[i] = cc < 31 ? p.rpb[((size_t)l * 6 + head) * 465 + rr * 31 + cc] * LOG2E : -INFINITY; }
    }
    int bcol[2][16];
    if (KIND == 2) {
#pragma unroll
        for (int t = 0; t < 2; ++t)
#pragma unroll
            for (int e = 0; e < 16; ++e) {
                const int kc = 32 * t + crow(e, h);
                bcol[t][e] = ((unsigned)(kc - c0) < 16u) ? (kc - qc + 15) * 4 : 31 * 4;
            }
    }
    f32x16 O0[2], O1[2];
#pragma unroll
    for (int t = 0; t < 2; ++t)
#pragma unroll
        for (int e = 0; e < 16; ++e) { O0[t][e] = 0.f; O1[t][e] = 0.f; }
    float l0 = 0.f, l1 = 0.f;
    const float zb = p.lam[8 + l * 4 + ((KIND == 1 && qcol >= 2048) ? 3 : KIND)];
    f32x16 cz;
#pragma unroll
    for (int e = 0; e < 16; ++e) cz[e] = -zb;

    const int kvoff = (8 * wave + (lane >> 3)) * 64 + (((lane & 7) ^ (((wave & 1) << 2) | (lane >> 4))) << 3);
    const int xr = (r >> 1) & 7;
    __syncthreads();
    KV_ISSUE(t1, 0);
    if (nt > 1) KV_ISSUE((1 < n1) ? t1 + 1 : t2 + (1 - n1), 1);
    int sc = 0, sn = 2;
    for (int it = 0; it < nt; ++it) {
        const int tile = (it < n1) ? t1 + it : t2 + (it - n1);
        if (it + 1 < nt) asm volatile("s_waitcnt vmcnt(4)" ::: "memory"); else asm volatile("s_waitcnt vmcnt(0)" ::: "memory");
        __builtin_amdgcn_s_barrier();
        const char* sk = smem + sc * ATT_SLOT;
        const char* sv = sk + ATT_V;
        bool active = true;
        if (KIND == 2 && tile < 32) active = (tile >= r0w) && (tile < r0w + 8);
        bf16x8 kf[8], vf[8];
        if (active) {
#pragma unroll
            for (int s = 0; s < 4; ++s)
#pragma unroll
                for (int t = 0; t < 2; ++t) kf[2 * s + t] = *(const bf16x8*)(sk + (32 * t + r) * 128 + (((2 * s + h) ^ xr) << 4));
        }
        __builtin_amdgcn_sched_barrier(0);
        if (it + 2 < nt) { const int nx = (it + 2 < n1) ? t1 + it + 2 : t2 + (it + 2 - n1); KV_ISSUE(nx, sn); }
        sc = (sc == 2) ? 0 : sc + 1; sn = (sn == 2) ? 0 : sn + 1;
        __builtin_amdgcn_sched_barrier(0);
        if (active) {
#define LOAD_VF() do { \
            __builtin_amdgcn_sched_barrier(0); \
            _Pragma("unroll") for (int s = 0; s < 4; ++s) \
                _Pragma("unroll") for (int dt = 0; dt < 2; ++dt) vf[2 * s + dt] = ldv_frag(sv, 32 * dt + r, 2 * s + h, xr); \
            __builtin_amdgcn_sched_barrier(0); } while (0)
            if (KIND == 0) {
                f32x16 S0[2], S1[2];
#pragma unroll
                for (int t = 0; t < 2; ++t) { S0[t] = MFMA(kf[t], qf[0], cz); S1[t] = MFMA(kf[4 + t], qf[2], cz); }
#pragma unroll
                for (int t = 0; t < 2; ++t) { S0[t] = MFMA(kf[2 + t], qf[1], S0[t]); S1[t] = MFMA(kf[6 + t], qf[3], S1[t]); }
                LOAD_VF();
                softmax_tile(S0, l0);
                pv_tile(S0, O0, vf);
                softmax_tile(S1, l1);
                pv_tile(S1, O1, vf);
            } else {
                f32x16 S[2];
#pragma unroll
                for (int t = 0; t < 2; ++t) S[t] = MFMA(kf[t], qf[0], cz);
#pragma unroll
                for (int s = 1; s < 4; ++s)
#pragma unroll
                    for (int t = 0; t < 2; ++t) S[t] = MFMA(kf[2 * s + t], qf[s], S[t]);
                LOAD_VF();
                if (KIND == 2 && tile < 32) {
                    const char* brow = smem + ATT_BIAS + (tile - nrow + 7) * 128;
#pragma unroll
                    for (int t = 0; t < 2; ++t)
#pragma unroll
                        for (int e = 0; e < 16; ++e) S[t][e] += *(const float*)(brow + bcol[t][e]);
                }
                softmax_tile(S, l0);
                pv_tile(S, O0, vf);
            }
#undef LOAD_VF
        }
    }
    l0 += __shfl_xor(l0, 32);
    const float inv0 = 1.f / l0;
    const int tid_e = otid();
    const size_t qrow_e = (size_t)b * TPB + qt * 128 + 32 * (tid_e >> 6) + (tid_e & 31);
    bf16_t* orow = p.hmix + ((size_t)(mixcol >> 5) * NTOK + qrow_e) * 32;
    const bf16_t* grow = p.qkv + ((size_t)(gcol >> 6) * NTOK + qrow_e) * 64;
    if (KIND == 0) {
        l1 += __shfl_xor(l1, 32);
        const float lam = p.lam[l];
        const float inv1 = lam / l1;
        float ss = 0.f;
#pragma unroll
        for (int t = 0; t < 2; ++t)
#pragma unroll
            for (int e = 0; e < 16; ++e) { const float o = O0[t][e] * inv0 - O1[t][e] * inv1; O0[t][e] = o; ss += o * o; }
        ss += __shfl_xor(ss, 32);
        const float rstd = rsqrtf(ss * (1.f / 64.f) + EPS) * p.lam[4 + l];
        const float* sw = p.subln + l * 64;
#pragma unroll
        for (int t = 0; t < 2; ++t)
#pragma unroll
            for (int q = 0; q < 4; ++q) {
                const int f = 32 * t + 8 * q + 4 * h;
                const float4 w4 = *(const float4*)(sw + f);
                const uint2 gg = *(const uint2*)(grow + f);
                const float g0 = bf2f((bf16_t)(gg.x & 0xffff)), g1 = bf2f((bf16_t)(gg.x >> 16)), g2 = bf2f((bf16_t)(gg.y & 0xffff)), g3 = bf2f((bf16_t)(gg.y >> 16));
                uint2 o;
                o.x = pk2(O0[t][4 * q + 0] * rstd * w4.x * g0, O0[t][4 * q + 1] * rstd * w4.y * g1);
                o.y = pk2(O0[t][4 * q + 2] * rstd * w4.z * g2, O0[t][4 * q + 3] * rstd * w4.w * g3);
                *(uint2*)(orow + (size_t)t * NTOK * 32 + 8 * q + 4 * h) = o;
            }
    } else {
#pragma unroll
        for (int t = 0; t < 2; ++t)
#pragma unroll
            for (int q = 0; q < 4; ++q) {
                const int f = 32 * t + 8 * q + 4 * h;
                const uint2 gg = *(const uint2*)(grow + f);
                const float g0 = bf2f((bf16_t)(gg.x & 0xffff)), g1 = bf2f((bf16_t)(gg.x >> 16)), g2 = bf2f((bf16_t)(gg.y & 0xffff)), g3 = bf2f((bf16_t)(gg.y >> 16));
                uint2 o;
                o.x = pk2(O0[t][4 * q + 0] * inv0 * g0, O0[t][4 * q + 1] * inv0 * g1);
                o.y = pk2(O0[t][4 * q + 2] * inv0 * g2, O0[t][4 * q + 3] * inv0 * g3);
                *(uint2*)(orow + (size_t)t * NTOK * 32 + 8 * q + 4 * h) = o;
            }
    }
}

template <int Q>
DI void attn_queue(const Params& p, int l, char* smem, int* s_unit, int cb) {
    const bool ctxu = l < DEPTH - 1;
    const int total = (Q == 0) ? (ctxu ? 576 : 512) : (Q == 1) ? (ctxu ? 960 : 768) : 768;
    for (;;) {
        if (threadIdx.x == 0) *s_unit = (int)atomicAdd(p.ctr + cb + l * 4 + Q, 1u);
        __syncthreads();
        const int u = *s_unit;
        __syncthreads();
        if (u >= total) break;
        if (Q == 0) {
            int b, head, qt, t1 = 0, n1 = 36;
            if (u < 512) { b = u >> 6; head = (u >> 4) & 3; qt = u & 15; }
            else { const int v = u - 512; b = v >> 3; head = (v >> 1) & 3; qt = 16 + (v & 1); t1 = 32; n1 = 4; }
            attn_unit<0>(p, l, b, head, qt, head * 64, 256 + head * 64, head * 64, 768 + head * 64, head * 64, t1, n1, 0, 0, smem);
        } else if (Q == 1) {
            int b, head, qt, t1 = 0, n1 = 36; bool cgrp = false;
            if (u < 768) { b = u / 96; head = (u >> 4) % 6; qt = u & 15; }
            else if (u < 864) { const int v = u - 768; b = v / 12; head = (v >> 1) % 6; qt = 16 + (v & 1); t1 = 32; n1 = 4; }
            else { const int v = u - 864; b = v / 12; head = (v >> 1) % 6; qt = 16 + (v & 1); t1 = 32; n1 = 4; cgrp = true; }
            int qcol, kcol, vfeat, gcol, mixcol;
            if (!cgrp) { const int kv = head / 3; qcol = 1024 + head * 64; kcol = 1408 + kv * 64; vfeat = 256 + kv * 64; gcol = 1664 + head * 64; mixcol = 256 + head * 64; }
            else { qcol = 2048 + head * 64; kcol = 2432 + head * 64; vfeat = 384 + head * 64; gcol = 3200 + head * 64; mixcol = 640 + head * 64; }
            attn_unit<1>(p, l, b, head, qt, qcol, kcol, vfeat, gcol, mixcol, t1, n1, 0, 0, smem);
        } else {
            const int b = u / 96, head = (u >> 4) % 6, qt = u & 15;
            const int t1 = min(max(2 * qt - 4, 0), 24), n1 = min(max(2 * qt + 1 - 4, 0), 24) + 8 - t1;
            attn_unit<2>(p, l, b, head, qt, 2048 + head * 64, 2432 + head * 64, 384 + head * 64, 3200 + head * 64, 640 + head * 64, t1, n1, 32, 4, smem);
        }
    }
}
DI void attn_phase(const Params& p, int l, char* smem, int cb) {
    __shared__ int s_unit;
    attn_queue<0>(p, l, smem, &s_unit, cb);
    attn_queue<1>(p, l, smem, &s_unit, cb);
    attn_queue<2>(p, l, smem, &s_unit, cb);
}

#define XB_TMO      128
#define XB_XCNT(j)  (256  + 64 * (j))
#define XB_XSUB(j)  (1280 + 64 * (j))
#define XB_XGEN(j)  (2304 + 64 * (j))
#define XB_TOP      3328
#define XB_TOPGEN   3392
#define XCD_BAR_WORDS 3456
#define XB_SPIN_CAP (1u << 20)
#define LAS __attribute__((address_space(3)))
DI unsigned xb_ld(unsigned* p)              { return __hip_atomic_load(p, __ATOMIC_RELAXED, __HIP_MEMORY_SCOPE_AGENT); }
DI unsigned xb_add(unsigned* p, unsigned v) { return __hip_atomic_fetch_add(p, v, __ATOMIC_RELAXED, __HIP_MEMORY_SCOPE_AGENT); }
DI unsigned xb_xcc_id() { return (unsigned)__builtin_amdgcn_s_getreg((3 << 11) | 20) & 0xFu; }
#define XB_SPIN(cond, bar) do { unsigned _sp = 0; while (cond) { __builtin_amdgcn_s_sleep(1); \
    if ((++_sp & 255u) == 0u) { if (xb_ld(&(bar)[XB_TMO])) break; if (_sp > XB_SPIN_CAP) { atomicAdd(&(bar)[XB_TMO], 1u); break; } } } } while (0)
struct XcdBarrier { unsigned* bar; unsigned x; volatile LAS unsigned* st; };
DI XcdBarrier xcd_barrier_post(unsigned* bar, volatile LAS unsigned* st) {
    XcdBarrier b; b.bar = bar; b.x = xb_xcc_id(); b.st = st;
    if (threadIdx.x == 0) (void)xb_add(&bar[XB_XCNT(b.x)], 1u);
    return b;
}
DI void xcd_barrier_complete(unsigned* bar, unsigned x, unsigned& nloc, unsigned& nx) {
    const unsigned G = gridDim.x * gridDim.y * gridDim.z;
    unsigned sum, cnt, mine, sp = 0u;
    for (;;) {
        sum = 0u; cnt = 0u; mine = 0u;
#pragma unroll
        for (unsigned j = 0; j < 16; ++j) { const unsigned c = xb_ld(&bar[XB_XCNT(j)]); sum += c; cnt += (c > 0u) ? 1u : 0u; mine = (j == x) ? c : mine; }
        if (sum == G) break;
        __builtin_amdgcn_s_sleep(1);
        if ((++sp & 255u) == 0u) { if (xb_ld(&bar[XB_TMO])) break; if (sp > XB_SPIN_CAP) { atomicAdd(&bar[XB_TMO], 1u); break; } }
    }
    nloc = mine > 0u ? mine : 1u; nx = cnt > 0u ? cnt : 1u;
}
DI void xcd_barrier(const XcdBarrier& b) {
    asm volatile("s_waitcnt vmcnt(0)" ::: "memory");
    __syncthreads();
    if (threadIdx.x == 0) {
        unsigned* bar = b.bar;
        __builtin_amdgcn_s_waitcnt(0);
        unsigned nloc = b.st[0], nx = b.st[1];
        if (nloc == 0u) { xcd_barrier_complete(bar, b.x, nloc, nx); b.st[0] = nloc; b.st[1] = nx; }
        const unsigned old = xb_add(&bar[XB_XSUB(b.x)], 1u);
        const unsigned gen = old / nloc;
        if (old + 1u == (gen + 1u) * nloc) {
            __builtin_amdgcn_fence(__ATOMIC_RELEASE, "agent");
            asm volatile("s_waitcnt vmcnt(0)" ::: "memory");
            const unsigned og = xb_add(&bar[XB_TOP], 1u);
            const unsigned tg = og / nx;
            if (og + 1u == (tg + 1u) * nx) xb_add(&bar[XB_TOPGEN], 1u);
            else XB_SPIN(xb_ld(&bar[XB_TOPGEN]) == tg, bar);
            __builtin_amdgcn_fence(__ATOMIC_ACQUIRE, "agent");
            xb_add(&bar[XB_XGEN(b.x)], 1u);
            asm volatile("s_waitcnt vmcnt(0)" ::: "memory");
        } else {
            XB_SPIN(xb_ld(&bar[XB_XGEN(b.x)]) == gen, bar);
            __builtin_amdgcn_fence(__ATOMIC_ACQUIRE, "agent");
            asm volatile("s_waitcnt vmcnt(0)" ::: "memory");
        }
    }
    __syncthreads();
}

__global__ void __launch_bounds__(NTHREADS, 2) mega(Params p_, int ph_lo, int ph_hi) {
    const Params& p = *(const Params*)__builtin_amdgcn_kernarg_segment_ptr();
    extern __shared__ __attribute__((aligned(16))) char smem[];
    cg::grid_group grid = cg::this_grid();
    __shared__ uint4 xb_words;
    if (threadIdx.x == 0) xb_words = make_uint4(0u, 0u, 0u, 0u);
    __syncthreads();
    XcdBarrier xb = xcd_barrier_post(p.bar, (volatile LAS unsigned*)&xb_words);
    for (int ph = ph_lo; ph < ph_hi; ++ph) {
        if (ph == 0) { prologue_phase(p, smem); if (DBL & 32) prologue_phase(p, smem); }
        else {
            const int l = (ph - 1) >> 2, s = (ph - 1) & 3;
            if (s == 0) { norm_phase(p, l); if (DBL & 1) norm_phase(p, l); }
            else if (s == 1) { inproj_phase(p, l, smem); if (DBL & 2) inproj_phase(p, l, smem); }
            else if (s == 2) { attn_phase(p, l, smem, 0); if (DBL & 4) attn_phase(p, l, smem, 16); }
            else { outproj_phase(p, l, smem); }
        }
        if (ph + 1 < ph_hi) {
            if (ph_hi > NPHASES) grid.sync();
            else { xcd_barrier(xb); if (DBL & 16) xcd_barrier(xb); }
        }
    }
}

extern "C" void kernel_launch(void* const* d_in, const int* in_sizes, int n_in, void* d_out, int out_size, void* d_ws, size_t ws_size,
                              hipStream_t stream) {
    static int grid_blocks = 0;
    if (grid_blocks == 0) {
        int dev = 0, cus = 0, per_cu = 0;
        hipGetDevice(&dev);
        hipDeviceGetAttribute(&cus, hipDeviceAttributeMultiprocessorCount, dev);
        if (hipFuncSetAttribute((const void*)mega, hipFuncAttributeMaxDynamicSharedMemorySize, LDS_BYTES) != hipSuccess) {
            fprintf(stderr, "kernel_launch: hipFuncSetAttribute failed\n"); grid_blocks = -1; return;
        }
        if (hipOccupancyMaxActiveBlocksPerMultiprocessor(&per_cu, (const void*)mega, NTHREADS, LDS_BYTES) != hipSuccess || per_cu < 1) {
            fprintf(stderr, "kernel_launch: occupancy query failed (%d)\n", per_cu); grid_blocks = -1; return;
        }
        if (per_cu > 2) per_cu = 2;
        grid_blocks = cus * per_cu;
        fprintf(stderr, "kernel_launch: %d CUs x %d blocks\n", cus, per_cu);
    }
    if (grid_blocks < 0) return;
    Params p{};
    const float* const* in = (const float* const*)d_in;
    p.x = in[0]; p.c = in[1]; p.ctx = in[2]; p.c_ctx = in[3]; p.norm_g = in[4]; p.w_ada = in[5]; p.b_ada = in[6]; p.w_in = in[7]; p.w_out = in[8];
    p.dqn = in[9]; p.dkn = in[10]; p.lq1 = in[11]; p.lk1 = in[12]; p.lq2 = in[13]; p.lk2 = in[14]; p.subln = in[15];
    p.gqn = in[16]; p.gkn = in[17]; p.nqn = in[18]; p.nkn = in[19]; p.rpb = in[20];
    p.out = (float*)d_out;
    char* w = (char*)d_ws;
    size_t off = 0;
    auto take = [&](size_t bytes) { char* q = w + off; off += (bytes + 255) & ~(size_t)255; return q; };
    p.ctr = (unsigned*)take(256);
    p.bar = (unsigned*)take(XCD_BAR_WORDS * 4);
    p.lam = (float*)take(256);
    p.mod = (float*)take((size_t)DEPTH * 9 * 3072 * 4);
    p.rope64 = (float*)take((size_t)SEQ * 64 * 4);
    p.rope32 = (float*)take((size_t)SEQ * 32 * 4);
    p.xctx = (float*)take((size_t)NB * CTXL * D * 4);
    p.hmix = (bf16_t*)take((size_t)NTOK * D * 2);
    p.qkv = (bf16_t*)take((size_t)NTOK * INW * 2);
    p.vT = (bf16_t*)take((size_t)NB * VW * TPB * 2);
    p.wtin = (bf16_t*)take((size_t)DEPTH * INW * D * 2);
    p.wtout = (bf16_t*)take((size_t)DEPTH * D * D * 2);
    if (off > ws_size) { fprintf(stderr, "kernel_launch: workspace too small (%zu > %zu)\n", off, ws_size); return; }
    if (hipMemsetAsync(p.ctr, 0, (size_t)((char*)p.lam - (char*)p.ctr), stream) != hipSuccess) { fprintf(stderr, "kernel_launch: memset failed\n"); return; }
#if N_LAUNCH_MODE == 1
    int lo = 0, hi = NPHASES;
    void* args[] = {&p, &lo, &hi};
    hipError_t e = hipLaunchCooperativeKernel((const void*)mega, dim3(grid_blocks), dim3(NTHREADS), args, LDS_BYTES, stream);
    if (e != hipSuccess) fprintf(stderr, "cooperative launch failed: %s (grid %d)\n", hipGetErrorString(e), grid_blocks);
#else
    for (int ph = 0; ph < NPHASES; ++ph) hipLaunchKernelGGL(mega, dim3(grid_blocks), dim3(NTHREADS), LDS_BYTES, stream, p, ph, ph + 1);
#endif
}
```
